# Optimizing an MI355X kernel written in HIP

```python
import math
import jax, jax.numpy as jnp
from jax import lax
import numpy as np

D_MODEL = 1024
BATCH = 16
SEQ = 2048
DEPTH = 2

CHUNK = 64
HEAD_DIM = 64
N_MAIN_HEADS = 12
N_MEM_HEADS = 4
MAIN_WIDTH = N_MAIN_HEADS * HEAD_DIM
MEM_WIDTH = N_MEM_HEADS * HEAD_DIM
MIX_WIDTH = MAIN_WIDTH + MEM_WIDTH
N_MEM = 256
D_FF = 2816
CONV_WIDTH = 3
Q_BLOCK = 128
N_A_LAYERS = DEPTH // 2
N_B_LAYERS = DEPTH - N_A_LAYERS
A_IN_WIDTH = 3 * MAIN_WIDTH + N_MAIN_HEADS + MEM_WIDTH
B_IN_WIDTH = MAIN_WIDTH + MEM_WIDTH
FORGET_BIAS_INIT = 3.0
FORGET_W_SCALE = 0.1
EPS = 1e-6

kernel_name = "yoco_fox_stickbreak_memory_convffn"


def rmsnorm(x, g):
    xf = x.astype(jnp.float32)
    y = xf * lax.rsqrt(jnp.mean(xf * xf, axis=-1, keepdims=True) + EPS)
    return (y * g.astype(jnp.float32)).astype(x.dtype)


def split_heads(t, n_heads):
    b, s, _ = t.shape
    return t.reshape(b, s, n_heads, HEAD_DIM).transpose(0, 2, 1, 3)


def merge_heads(t):
    b, n, s, d = t.shape
    return t.transpose(0, 2, 1, 3).reshape(b, s, n * d)


def forgetting_attention(q, k, v, log_f):
    seq = q.shape[2]
    c = jnp.cumsum(log_f, axis=-1)
    scale = HEAD_DIM ** -0.5
    outs = []
    for i in range(seq // Q_BLOCK):
        q0, q1 = i * Q_BLOCK, (i + 1) * Q_BLOCK
        kb, vb = k[:, :, :q1], v[:, :, :q1]
        logits = jnp.einsum('bhqd,bhkd->bhqk', q[:, :, q0:q1], kb).astype(jnp.float32) * scale
        logits = logits + c[:, :, q0:q1, None] - c[:, :, None, :q1]
        t_idx = jnp.arange(q0, q1)[:, None]
        s_idx = jnp.arange(q1)[None, :]
        logits = jnp.where(s_idx <= t_idx, logits, -jnp.inf)
        p = jax.nn.softmax(logits, axis=-1)
        outs.append(jnp.einsum('bhqk,bhkd->bhqd', p.astype(vb.dtype), vb))
    return jnp.concatenate(outs, axis=2)


def stick_breaking_attention(q, k, v):
    seq = q.shape[2]
    scale = HEAD_DIM ** -0.5
    outs = []
    for i in range(seq // Q_BLOCK):
        q0, q1 = i * Q_BLOCK, (i + 1) * Q_BLOCK
        kb, vb = k[:, :, :q1], v[:, :, :q1]
        z = jnp.einsum('bhqd,bhkd->bhqk', q[:, :, q0:q1], kb).astype(jnp.float32) * scale
        t_idx = jnp.arange(q0, q1)[:, None]
        s_idx = jnp.arange(q1)[None, :]
        causal = s_idx < t_idx
        log_1m_beta = jnp.where(causal, jax.nn.log_sigmoid(-z), 0.0)
        cum = jnp.cumsum(log_1m_beta, axis=-1)
        log_a = jax.nn.log_sigmoid(z) + cum[..., -1:] - cum
        a = jnp.where(causal, jnp.exp(log_a), 0.0)
        outs.append(jnp.einsum('bhqk,bhkd->bhqd', a.astype(vb.dtype), vb))
    return jnp.concatenate(outs, axis=2)


def memory_attention(q, mem_k, mem_v):
    logits = jnp.einsum('bhqd,bhmd->bhqm', q, mem_k).astype(jnp.float32) * (HEAD_DIM ** -0.5)
    p = jax.nn.softmax(logits, axis=-1)
    return jnp.einsum('bhqm,bhmd->bhqd', p.astype(mem_v.dtype), mem_v)


def conv_ffn(h, w_up, conv_w, conv_b, w_down):
    u = h @ w_up
    s = u.shape[1]
    up = jnp.pad(u, ((0, 0), (CONV_WIDTH - 1, 0), (0, 0)))
    uc = conv_b
    for j in range(CONV_WIDTH):
        uc = uc + conv_w[j] * up[:, j:j + s]
    gate, val = jnp.split(uc, 2, axis=-1)
    return (jax.nn.silu(gate) * val) @ w_down


def setup_inputs(seed: int = 0) -> dict:
    key = jax.random.key(seed)
    ks = jax.random.split(key, 17)
    f32 = jnp.float32

    def nrm(k, shape, scale):
        return jax.random.normal(k, shape, f32) * scale

    def gain(k, shape):
        return 1.0 + 0.05 * jax.random.normal(k, shape, f32)

    x = nrm(ks[0], (BATCH, SEQ, D_MODEL), 1.0)
    mem = nrm(ks[1], (BATCH, N_MEM, D_MODEL), 1.0)
    ln_mix_g = gain(ks[2], (DEPTH, D_MODEL))
    w_in_a = nrm(ks[3], (N_A_LAYERS, D_MODEL, A_IN_WIDTH), D_MODEL ** -0.5)
    w_in_a = w_in_a.at[:, :, 3 * MAIN_WIDTH:3 * MAIN_WIDTH + N_MAIN_HEADS].multiply(FORGET_W_SCALE)
    b_f_a = FORGET_BIAS_INIT + 0.5 * jax.random.normal(ks[4], (N_A_LAYERS, N_MAIN_HEADS), f32)
    w_in_b = nrm(ks[5], (N_B_LAYERS, D_MODEL, B_IN_WIDTH), D_MODEL ** -0.5)
    ln_kv_g = gain(ks[6], (D_MODEL,))
    w_kv = nrm(ks[7], (D_MODEL, 2 * MAIN_WIDTH), D_MODEL ** -0.5)
    ln_mem_g = gain(ks[8], (DEPTH, D_MODEL))
    w_memkv = nrm(ks[9], (DEPTH, D_MODEL, 2 * MEM_WIDTH), D_MODEL ** -0.5)
    w_out = nrm(ks[10], (DEPTH, MIX_WIDTH, D_MODEL), MIX_WIDTH ** -0.5)
    ln_ffn_g = gain(ks[11], (DEPTH, D_MODEL))
    w_up = nrm(ks[12], (DEPTH, D_MODEL, 2 * D_FF), D_MODEL ** -0.5)
    conv_w = nrm(ks[13], (DEPTH, CONV_WIDTH, 2 * D_FF), CONV_WIDTH ** -0.5)
    conv_b = nrm(ks[14], (DEPTH, 2 * D_FF), 0.02)
    w_down = nrm(ks[15], (DEPTH, D_FF, D_MODEL), D_FF ** -0.5)
    final_g = gain(ks[16], (D_MODEL,))
    return {'x': x, 'mem': mem, 'ln_mix_g': ln_mix_g, 'w_in_a': w_in_a, 'b_f_a': b_f_a,
            'w_in_b': w_in_b, 'ln_kv_g': ln_kv_g, 'w_kv': w_kv, 'ln_mem_g': ln_mem_g,
            'w_memkv': w_memkv, 'w_out': w_out, 'ln_ffn_g': ln_ffn_g, 'w_up': w_up,
            'conv_w': conv_w, 'conv_b': conv_b, 'w_down': w_down, 'final_g': final_g}


def reference(x, mem, ln_mix_g, w_in_a, b_f_a, w_in_b, ln_kv_g, w_kv, ln_mem_g,
              w_memkv, w_out, ln_ffn_g, w_up, conv_w, conv_b, w_down, final_g):
    k_sh = None
    v_sh = None
    for layer in range(DEPTH):
        h = rmsnorm(x, ln_mix_g[layer])
        if layer < N_A_LAYERS:
            proj = h @ w_in_a[layer]
            q, k, v, f_logit, q_mem = jnp.split(
                proj, [MAIN_WIDTH, 2 * MAIN_WIDTH, 3 * MAIN_WIDTH, 3 * MAIN_WIDTH + N_MAIN_HEADS], axis=-1)
            log_f = jax.nn.log_sigmoid((f_logit + b_f_a[layer]).astype(jnp.float32))
            o_main = forgetting_attention(split_heads(q, N_MAIN_HEADS), split_heads(k, N_MAIN_HEADS),
                                          split_heads(v, N_MAIN_HEADS), log_f.transpose(0, 2, 1))
        else:
            if layer == N_A_LAYERS:
                kv = rmsnorm(x, ln_kv_g) @ w_kv
                k_s, v_s = jnp.split(kv, 2, axis=-1)
                k_sh = split_heads(k_s, N_MAIN_HEADS)
                v_sh = split_heads(v_s, N_MAIN_HEADS)
            proj = h @ w_in_b[layer - N_A_LAYERS]
            q, q_mem = jnp.split(proj, [MAIN_WIDTH], axis=-1)
            o_main = stick_breaking_attention(split_heads(q, N_MAIN_HEADS), k_sh, v_sh)
        mem_kv = rmsnorm(mem, ln_mem_g[layer]) @ w_memkv[layer]
        mk, mv = jnp.split(mem_kv, 2, axis=-1)
        o_mem = memory_attention(split_heads(q_mem, N_MEM_HEADS), split_heads(mk, N_MEM_HEADS),
                                 split_heads(mv, N_MEM_HEADS))
        o = jnp.concatenate([merge_heads(o_main), merge_heads(o_mem)], axis=-1) @ w_out[layer]
        x = x + o
        x = x + conv_ffn(rmsnorm(x, ln_ffn_g[layer]), w_up[layer], conv_w[layer], conv_b[layer], w_down[layer])
    return rmsnorm(x, final_g)
```

```cpp
#include <hip/hip_runtime.h>
#include <hip/hip_cooperative_groups.h>
#include <cstdio>
#include <cstdint>
#include <cmath>
namespace cg = cooperative_groups;
__device__ __forceinline__ int opaque_tid() { int t = threadIdx.x; asm volatile("" : "+v"(t)); return t; }
namespace pg8 {
#define PG8_LAS __attribute__((address_space(3)))
typedef unsigned short bf16_t;
typedef short bf16x8 __attribute__((ext_vector_type(8)));
typedef float f32x4 __attribute__((ext_vector_type(4)));
typedef unsigned u32x4 __attribute__((ext_vector_type(4)));
constexpr int BM = 256, BK = 64, HALF = 128, HTB = HALF * BK * 2  , STAGE_BYTES = 8 * HTB, NXCD = 8, WGM = 4;

__host__ __device__ __forceinline__ int lds_byte(int r, int c) { const int st = (r >> 4) * 2 + (c >> 5), rr = r & 15, cc = c & 31, ob = rr * 64 + cc * 2; return st * 1024 + (ob ^ (((ob >> 9) & 1) << 5)); }
__host__ __device__ __forceinline__ void stage_rc(int b, int& R, int& C) { const int st = b / 1024, sb = b % 1024, swz = sb ^ (((sb >> 9) & 1) << 5); R = (st >> 1) * 16 + swz / 64; C = (st & 1) * 32 + (swz % 64) / 2; }
__host__ __device__ __forceinline__ int perm32(int rho) { const int n = rho >> 4, i = rho & 15; return 8 * (i >> 2) + 4 * n + (i & 3); }

struct Unit { int pm, pn; };
struct Gemm { const bf16_t* A; const bf16_t* Bt; int M, N, K; };

struct StaticOrder {
    int nM, nN, nwg, G, c;
    __host__ __device__ __forceinline__ void init(int M, int N, int G_, int c_) { nM = M / BM; nN = N / BM; nwg = nM * nN; G = G_; c = c_; }
    __host__ __device__ __forceinline__ bool next(int i, Unit& u) const {
        const long L = (long)i * G + c; if (L >= nwg) return false;
        int wgid = (int)L; { const int q = nwg / NXCD, r = nwg % NXCD, xcd = wgid % NXCD, off = wgid / NXCD; wgid = (xcd < r ? xcd * (q + 1) : r * (q + 1) + (xcd - r) * q) + off; }
        const int nig = WGM * nN, gid = wgid / nig, fm = gid * WGM, gsz = (nM - fm) < WGM ? (nM - fm) : WGM;
        u.pm = fm + ((wgid % nig) % gsz); u.pn = (wgid % nig) / gsz; return true;
    }
    __device__ __forceinline__ void a_ready(const Unit&) const {}
    __device__ __forceinline__ void done(const Unit&) const {}
};

constexpr int PREF_SLOT = 5120;
struct PrefOrder : StaticOrder {
    const float* ssq; const float* cw; const float* cb; PG8_LAS unsigned char* area; mutable int n;
    __device__ __forceinline__ void a_ready(const Unit& u) const {
        const int tid = opaque_tid(), lane = tid & 63, wid = __builtin_amdgcn_readfirstlane(tid >> 6);
        PG8_LAS unsigned char* slot = area + (n & 1) * PREF_SLOT; ++n;
        if (wid < 4) __builtin_amdgcn_global_load_lds((const unsigned*)(ssq + (size_t)u.pm * BM + wid * 64 + lane), (PG8_LAS unsigned*)(slot + wid * 256), 4, 0, 0);
        if (cw) { const int kk = wid & 3; const float* src = (kk < 3 ? cw + kk * 5632 : cb) + (wid >= 4 ? 2816 : 0) + u.pn * 128 + lane;
            __builtin_amdgcn_global_load_lds((const unsigned*)src, (PG8_LAS unsigned*)(slot + 1024 + wid * 512), 4, 0, 0);
            __builtin_amdgcn_global_load_lds((const unsigned*)(src + 64), (PG8_LAS unsigned*)(slot + 1024 + wid * 512 + 256), 4, 0, 0); }
    }
};

__device__ __forceinline__ unsigned cvt_pk_bf16(float lo, float hi) { unsigned r; asm volatile("v_cvt_pk_bf16_f32 %0, %1, %2" : "=v"(r) : "v"(lo), "v"(hi)); return r; }
typedef unsigned u32x2 __attribute__((ext_vector_type(2)));
constexpr float LOG2E = 1.4426950408889634f;
constexpr float QC2 = 0.125f * 1.4426950408889634f;
constexpr float NEPS = 1e-6f;

struct EpiProj {
    static constexpr bool PERM = true, AFTER_DRAIN = false, APERM = true;
    int variant;
    const PG8_LAS unsigned char* area; mutable int n;
    bf16_t *Q, *K, *VT, *QM; float* LOGF; const float* bf; float qscale;
    __device__ __forceinline__ void operator()(const f32x4 (&acc)[2][2][4][2], const Unit& u, int wr, int wc, int fr, int fq) const {
        const int row0 = u.pm * BM + wr * 64 + 4 * fr; const int pn = u.pn;
        const PG8_LAS float* pre = (const PG8_LAS float*)(area + (n & 1) * PREF_SLOT); ++n;
        float rs[2][4];
#pragma unroll
        for (int ai = 0; ai < 2; ++ai)
#pragma unroll
            for (int m = 0; m < 4; ++m) rs[ai][m] = rsqrtf(pre[wr * 64 + 4 * fr + ai * HALF + m] * (1.0f / 1024.0f) + NEPS);
        int kind = 0, pitch = 768, cb = 0, S_ = 2048, sh = 11, ncols = 768; bf16_t* dst = Q; float sc = 1.f; bool khm = false;
        if (variant == 2) { S_ = 256; sh = 8; ncols = 256; pitch = 256; if (pn == 0) { kind = 0; dst = K; } else { kind = 1; dst = VT; } }
        else if (pn >= 10) { kind = 2; }
        else if (pn == 9) { kind = 0; dst = QM; pitch = 256; sc = QC2; }
        else { const int g = pn / 3; cb = 256 * (pn - 3 * g); const int role = (variant == 0) ? g : (g == 0 ? 1 : (g == 1 ? 2 : 0));
               if (role == 0) { kind = 0; dst = Q; sc = qscale; } else if (role == 1) { kind = 0; dst = K; khm = true; } else { kind = 1; dst = VT; } }
        if (kind == 0) {
#pragma unroll
            for (int ai = 0; ai < 2; ++ai)
#pragma unroll
                for (int m = 0; m < 4; ++m) { const int row = row0 + ai * HALF + m; const float s = rs[ai][m] * sc;
                    const int c0 = cb + wc * 32 + 8 * fq;
                    bf16_t* rowp = khm ? dst + (((size_t)(row >> 11) * 12 + (c0 >> 6)) * 2048 + (row & 2047)) * 64 + (c0 & 63) : dst + (size_t)row * pitch + c0;
                    const size_t bjs = khm ? (size_t)2 * 2048 * 64 : (size_t)HALF;
#pragma unroll
                    for (int bj = 0; bj < 2; ++bj) { const f32x4 v0 = acc[ai][bj][m][0] * s, v1 = acc[ai][bj][m][1] * s; u32x4 w;
                        w.x = cvt_pk_bf16(v0[0], v0[1]); w.y = cvt_pk_bf16(v0[2], v0[3]); w.z = cvt_pk_bf16(v1[0], v1[1]); w.w = cvt_pk_bf16(v1[2], v1[3]);
                        *(u32x4*)(rowp + bj * bjs) = w; }
                    asm volatile("" ::: "memory"); }
        } else if (kind == 1) {
#pragma unroll
            for (int ai = 0; ai < 2; ++ai) { const int rowa = row0 + ai * HALF;
                bf16_t* bp = dst + ((size_t)(rowa >> sh) * ncols) * S_ + (rowa & (S_ - 1));
#pragma unroll
                for (int bj = 0; bj < 2; ++bj)
#pragma unroll
                    for (int n = 0; n < 2; ++n) { const int col = cb + bj * HALF + wc * 32 + 8 * fq + 4 * n;
                        const f32x4 v0 = acc[ai][bj][0][n] * rs[ai][0], v1 = acc[ai][bj][1][n] * rs[ai][1], v2 = acc[ai][bj][2][n] * rs[ai][2], v3 = acc[ai][bj][3][n] * rs[ai][3];
#pragma unroll
                        for (int j = 0; j < 4; ++j) { u32x2 w; w.x = cvt_pk_bf16(v0[j], v1[j]); w.y = cvt_pk_bf16(v2[j], v3[j]); *(u32x2*)(bp + (size_t)(col + j) * S_) = w; } }
                asm volatile("" ::: "memory"); }
        } else {
            if (wc == 0 && fq < 2) {
#pragma unroll
                for (int ai = 0; ai < 2; ++ai)
#pragma unroll
                    for (int m = 0; m < 4; ++m) { const int row = row0 + ai * HALF + m; const float s = rs[ai][m];
#pragma unroll
                        for (int n = 0; n < 2; ++n) { const f32x4 v = acc[ai][0][m][n] * s;
#pragma unroll
                            for (int j = 0; j < 4; ++j) { const int col = 8 * fq + 4 * n + j;
                                if (col < 12) { const float f = v[j] + bf[col]; const float ls = -(fmaxf(-f, 0.f) + __logf(1.f + __expf(-fabsf(f))));
                                    LOGF[((size_t)(row >> 11) * 12 + col) * 2048 + (row & 2047)] = ls * LOG2E; } } } }
            }
        }
    }
};

struct EpiRes {
    static constexpr bool PERM = true, AFTER_DRAIN = false, APERM = false;
    const float* basef; bf16_t* xb; float* ssq; int dry;
    __device__ __forceinline__ void operator()(const f32x4 (&acc)[2][2][4][2], const Unit& u, int wr, int wc, int fr, int fq) const {
        const int row0 = u.pm * BM + wr * 64 + fr, col0 = u.pn * BM + wc * 32 + 8 * fq;
#pragma unroll
        for (int ai = 0; ai < 2; ++ai) {
            u32x4 bw[4][2];
            if (!basef) {
#pragma unroll
                for (int m = 0; m < 4; ++m)
#pragma unroll
                    for (int bj = 0; bj < 2; ++bj) bw[m][bj] = *(const u32x4*)(xb + (size_t)(row0 + ai * HALF + m * 16) * 1024 + col0 + bj * HALF);
            }
#pragma unroll
            for (int m = 0; m < 4; ++m) { const int row = row0 + ai * HALF + m * 16; const size_t off = (size_t)row * 1024 + col0; float s = 0.f;
#pragma unroll
                for (int bj = 0; bj < 2; ++bj) { const size_t o2 = off + bj * HALF; f32x4 b0, b1;
                    if (basef) { b0 = *(const f32x4*)(basef + o2); b1 = *(const f32x4*)(basef + o2 + 4); }
                    else { const u32x4 w = bw[m][bj];
                        b0 = (f32x4){__uint_as_float(w.x << 16), __uint_as_float(w.x & 0xffff0000u), __uint_as_float(w.y << 16), __uint_as_float(w.y & 0xffff0000u)};
                        b1 = (f32x4){__uint_as_float(w.z << 16), __uint_as_float(w.z & 0xffff0000u), __uint_as_float(w.w << 16), __uint_as_float(w.w & 0xffff0000u)}; }
                    const f32x4 x0 = b0 + acc[ai][bj][m][0], x1 = b1 + acc[ai][bj][m][1];
                    s += ((x0[0] * x0[0] + x0[1] * x0[1]) + (x0[2] * x0[2] + x0[3] * x0[3])) + ((x1[0] * x1[0] + x1[1] * x1[1]) + (x1[2] * x1[2] + x1[3] * x1[3]));
                    if (!dry) { u32x4 w; w.x = cvt_pk_bf16(x0[0], x0[1]); w.y = cvt_pk_bf16(x0[2], x0[3]); w.z = cvt_pk_bf16(x1[0], x1[1]); w.w = cvt_pk_bf16(x1[2], x1[3]); *(u32x4*)(xb + o2) = w; } }
                s += __shfl_xor(s, 16); s += __shfl_xor(s, 32);
                if (fq == 0 && !dry) atomicAdd(ssq + row, s); }
            asm volatile("" ::: "memory");
        }
    }
};

__device__ __forceinline__ float ror1(float x) { return __builtin_bit_cast(float, __builtin_amdgcn_mov_dpp(__builtin_bit_cast(int, x), 0x121, 0xf, 0xf, false)); }
__device__ __forceinline__ float ror2(float x) { return __builtin_bit_cast(float, __builtin_amdgcn_mov_dpp(__builtin_bit_cast(int, x), 0x122, 0xf, 0xf, false)); }
__device__ __forceinline__ float shr1(float old, float x) { return __builtin_bit_cast(float, __builtin_amdgcn_update_dpp(__builtin_bit_cast(int, old), __builtin_bit_cast(int, x), 0x111, 0xf, 0xf, false)); }
__device__ __forceinline__ float shr2(float old, float x) { return __builtin_bit_cast(float, __builtin_amdgcn_update_dpp(__builtin_bit_cast(int, old), __builtin_bit_cast(int, x), 0x112, 0xf, 0xf, false)); }
struct EpiUp {
    static constexpr bool PERM = true, AFTER_DRAIN = false, APERM = true;
    const PG8_LAS unsigned char* area; mutable int n; bf16_t* act; float* halo; int dry;
    static __device__ __forceinline__ float shr1z(float x) { return __builtin_bit_cast(float, __builtin_amdgcn_mov_dpp(__builtin_bit_cast(int, x), 0x111, 0xf, 0xf, true)); }
    __device__ __forceinline__ void operator()(const f32x4 (&acc)[2][2][4][2], const Unit& u, int wr, int wc, int fr, int fq) const {
        const int rbase = u.pm * BM + wr * 64 + 4 * fr;
        const PG8_LAS float* pre = (const PG8_LAS float*)(area + (n & 1) * PREF_SLOT); ++n;
        if (dry) {
            f32x4 t = {0.f, 0.f, 0.f, 0.f};
#pragma unroll
            for (int ai = 0; ai < 2; ++ai)
#pragma unroll
                for (int bj = 0; bj < 2; ++bj)
#pragma unroll
                    for (int m = 0; m < 4; ++m) { t += acc[ai][bj][m][0]; t += acc[ai][bj][m][1]; }
            if (t[0] + t[1] + t[2] + t[3] == 12345.6789f) halo[rbase] = t[0];
            return;
        }
        float rs[2][4];
#pragma unroll
        for (int ai = 0; ai < 2; ++ai)
#pragma unroll
            for (int m = 0; m < 4; ++m) rs[ai][m] = rsqrtf(pre[wr * 64 + 4 * fr + ai * HALF + m] * (1.0f / 1024.0f) + NEPS);
        const PG8_LAS float* pl = pre + 256 + wc * 32;
#pragma unroll
        for (int n = 0; n < 2; ++n) {
            const int f = u.pn * 128 + wc * 32 + 8 * fq + 4 * n;
            const int po = 8 * fq + 4 * n;
#pragma unroll
            for (int ai = 0; ai < 2; ++ai) {
                const int grp = u.pm * 4 + ai * 2 + wr;
                float* hp = halo + ((size_t)(grp * 4 + (fr == 0 ? 0 : 2)) * 2) * 2816 + f;
                f32x4 cg[4];
                {
                    const f32x4 g0 = *(const PG8_LAS f32x4*)(pl + po), g1 = *(const PG8_LAS f32x4*)(pl + 128 + po), g2 = *(const PG8_LAS f32x4*)(pl + 256 + po), gb = *(const PG8_LAS f32x4*)(pl + 384 + po);
                    f32x4 ug[4];
#pragma unroll
                    for (int m = 0; m < 4; ++m) ug[m] = acc[ai][0][m][n] * rs[ai][m];
                    f32x4 s3, s2;
#pragma unroll
                    for (int j = 0; j < 4; ++j) { s3[j] = shr1z(ug[3][j]); s2[j] = shr1z(ug[2][j]); }
                    cg[0] = gb + g0 * s2 + g1 * s3 + g2 * ug[0]; cg[1] = gb + g0 * s3 + g1 * ug[0] + g2 * ug[1];
                    cg[2] = gb + g0 * ug[0] + g1 * ug[1] + g2 * ug[2]; cg[3] = gb + g0 * ug[1] + g1 * ug[2] + g2 * ug[3];
                    if (fr == 0 || fr == 15) { *(f32x4*)hp = fr == 0 ? ug[0] : ug[2]; *(f32x4*)(hp + 5632) = fr == 0 ? ug[1] : ug[3]; }
                }
                {
                    const f32x4 v0 = *(const PG8_LAS f32x4*)(pl + 512 + po), v1 = *(const PG8_LAS f32x4*)(pl + 640 + po), v2 = *(const PG8_LAS f32x4*)(pl + 768 + po), vb = *(const PG8_LAS f32x4*)(pl + 896 + po);
                    f32x4 uv[4];
#pragma unroll
                    for (int m = 0; m < 4; ++m) uv[m] = acc[ai][1][m][n] * rs[ai][m];
                    f32x4 s3, s2;
#pragma unroll
                    for (int j = 0; j < 4; ++j) { s3[j] = shr1z(uv[3][j]); s2[j] = shr1z(uv[2][j]); }
                    f32x4 cv[4];
                    cv[0] = vb + v0 * s2 + v1 * s3 + v2 * uv[0]; cv[1] = vb + v0 * s3 + v1 * uv[0] + v2 * uv[1];
                    cv[2] = vb + v0 * uv[0] + v1 * uv[1] + v2 * uv[2]; cv[3] = vb + v0 * uv[1] + v1 * uv[2] + v2 * uv[3];
                    if (fr == 0 || fr == 15) { *(f32x4*)(hp + 2816) = fr == 0 ? uv[0] : uv[2]; *(f32x4*)(hp + 5632 + 2816) = fr == 0 ? uv[1] : uv[3]; }
#pragma unroll
                    for (int m = 0; m < 4; ++m) { f32x4 r;
#pragma unroll
                        for (int j = 0; j < 4; ++j) { const float e = __builtin_amdgcn_exp2f(-cg[m][j] * LOG2E); r[j] = cg[m][j] * __builtin_amdgcn_rcpf(1.f + e) * cv[m][j]; }
                        u32x2 w; w.x = cvt_pk_bf16(r[0], r[1]); w.y = cvt_pk_bf16(r[2], r[3]);
                        *(u32x2*)(act + (size_t)(rbase + ai * HALF + m) * 2816 + f) = w; }
                }
                asm volatile("" ::: "memory");
            }
        }
    }
};
template <class Epi, class Sched, bool ALIGN_EPI = false, bool SP2 = false>
__device__ __forceinline__ void gemm_phase(PG8_LAS unsigned char* lds, const Gemm g, const Sched& S, const Epi& E) {
    const int tid = opaque_tid(), wid = __builtin_amdgcn_readfirstlane(tid >> 6), lane = tid & 63, wr = wid >> 2, wc = wid & 3, fr = lane & 15, fq = lane >> 4;
    const int K = g.K, nt = K / BK;
    unsigned voffA[2], voffB[2];
#pragma unroll
    for (int i = 0; i < 2; ++i) { int R, C; stage_rc(tid * 16 + i * 8192, R, C); const int Rb = Epi::PERM ? ((R & ~31) + perm32(R & 31)) : R;
        const int Ra = Epi::APERM ? ((R & 64) + 4 * (R & 15) + ((R >> 4) & 3)) : R;
        voffA[i] = (unsigned)(Ra * K + C) * 2u; voffB[i] = (unsigned)(Rb * K + C) * 2u; }
    const size_t kstep = (size_t)(BK * 2);
    const size_t hstep = (size_t)HALF * K * 2;
    const size_t tstep = 2 * hstep;
    const unsigned ldsw = (unsigned)wid * 1024u;
    const int aoff = lds_byte(wr * 64 + fr, fq * 8), boff = lds_byte(wc * 32 + fr, fq * 8);
#define PG8_SA(b, h) (((b) * 2 + (h)) * HTB)
#define PG8_SB(b, h) ((4 + (b) * 2 + (h)) * HTB)
#define PG8_STAGE(bufoff, gbase, voff) do { _Pragma("unroll") for (int _i = 0; _i < 2; ++_i) \
        __builtin_amdgcn_global_load_lds((const unsigned*)((const char*)(gbase) + (voff)[_i]), (PG8_LAS unsigned*)(lds + (bufoff) + ldsw + _i * 8192), 16, 0, 0); } while (0)
#define PG8_LDA(dst, b, h) do { _Pragma("unroll") for (int m = 0; m < 4; ++m) _Pragma("unroll") for (int k = 0; k < 2; ++k) dst[m][k] = *(const PG8_LAS bf16x8*)(lds + PG8_SA(b, h) + aoff + m * 2048 + k * 1024); } while (0)
#define PG8_LDB(dst, b, h) do { _Pragma("unroll") for (int n = 0; n < 2; ++n) _Pragma("unroll") for (int k = 0; k < 2; ++k) dst[n][k] = *(const PG8_LAS bf16x8*)(lds + PG8_SB(b, h) + boff + n * 2048 + k * 1024); } while (0)
#define PG8_MMA(ai, bj, At, Bt) do { __builtin_amdgcn_s_setprio(1); _Pragma("unroll") for (int m = 0; m < 4; ++m) _Pragma("unroll") for (int n = 0; n < 2; ++n) _Pragma("unroll") for (int k = 0; k < 2; ++k) \
        acc[ai][bj][m][n] = __builtin_amdgcn_mfma_f32_16x16x32_bf16(Bt[n][k], At[m][k], acc[ai][bj][m][n], 0, 0, 0); __builtin_amdgcn_s_setprio(0); } while (0)
#define PG8_WAIT_V(n) asm volatile("s_waitcnt vmcnt(" #n ")" ::: "memory")
#define PG8_WAIT_L(n) asm volatile("s_waitcnt lgkmcnt(" #n ")" ::: "memory")
#define PG8_BAR __builtin_amdgcn_s_barrier()
#define PG8_SCHED __builtin_amdgcn_sched_barrier(0)
    Unit cur, nxt; int ui = 0;
    if (!S.next(0, cur)) return;
    f32x4 acc[2][2][4][2];
#pragma unroll
    for (int a = 0; a < 2; ++a)
#pragma unroll
        for (int b = 0; b < 2; ++b)
#pragma unroll
            for (int m = 0; m < 4; ++m)
#pragma unroll
                for (int n = 0; n < 2; ++n) acc[a][b][m][n] = (f32x4){0.f, 0.f, 0.f, 0.f};
    bf16x8 At[4][2], B0[2][2], B1[2][2];
    const char* cA = (const char*)g.A + (size_t)cur.pm * tstep; const char* cB = (const char*)g.Bt + (size_t)cur.pn * tstep;
    S.a_ready(cur);
    if constexpr (SP2) {
        PG8_STAGE(PG8_SB(0, 0), cB, voffB); PG8_STAGE(PG8_SB(0, 1), cB + hstep, voffB); PG8_STAGE(PG8_SA(0, 0), cA, voffA); PG8_STAGE(PG8_SA(0, 1), cA + hstep, voffA);
        if (wr == 1) PG8_BAR;
        PG8_WAIT_V(2); PG8_BAR;
        PG8_STAGE(PG8_SB(1, 0), cB + kstep, voffB); PG8_STAGE(PG8_SA(1, 0), cA + kstep, voffA); PG8_STAGE(PG8_SB(1, 1), cB + hstep + kstep, voffB);
        PG8_WAIT_V(6); PG8_BAR;
    } else {
        PG8_STAGE(PG8_SB(0, 0), cB, voffB); PG8_STAGE(PG8_SA(0, 0), cA, voffA); PG8_STAGE(PG8_SB(0, 1), cB + hstep, voffB); PG8_STAGE(PG8_SA(0, 1), cA + hstep, voffA);
        if (wr == 1) PG8_BAR;
        PG8_WAIT_V(4); PG8_BAR;
        PG8_STAGE(PG8_SB(1, 0), cB + kstep, voffB); PG8_STAGE(PG8_SA(1, 0), cA + kstep, voffA); PG8_STAGE(PG8_SB(1, 1), cB + hstep + kstep, voffB);
        PG8_WAIT_V(6); PG8_BAR;
    }
    for (;;) {
        const bool has_next = S.next(ui + 1, nxt);
        const char* nA = has_next ? (const char*)g.A + (size_t)nxt.pm * tstep : cA; const char* nB = has_next ? (const char*)g.Bt + (size_t)nxt.pn * tstep : cB;
        for (int t = 0; t < nt; t += 2) {
            const bool last = (t == nt - 2);
            const char* a1 = cA + (size_t)(t + 1) * kstep;
            const char* a2 = last ? nA : cA + (size_t)(t + 2) * kstep; const char* b2 = last ? nB : cB + (size_t)(t + 2) * kstep;
            const char* a3 = a2 + kstep; const char* b3 = b2 + kstep;
            if (last && has_next) S.a_ready(nxt);
            if constexpr (SP2) {
            PG8_LDB(B0, 0, 0); PG8_LDB(B1, 0, 1); PG8_SCHED; PG8_LDA(At, 0, 0); PG8_STAGE(PG8_SA(1, 1), a1 + hstep, voffA);
            PG8_WAIT_V(8); PG8_WAIT_L(0); PG8_BAR; PG8_MMA(0, 0, At, B0); PG8_MMA(0, 1, At, B1); PG8_BAR; PG8_SCHED;
            PG8_LDA(At, 0, 1); PG8_STAGE(PG8_SB(0, 0), b2, voffB); PG8_STAGE(PG8_SB(0, 1), b2 + hstep, voffB); PG8_STAGE(PG8_SA(0, 0), a2, voffA);
            PG8_WAIT_V(8); PG8_WAIT_L(0); PG8_BAR; PG8_MMA(1, 0, At, B0); PG8_MMA(1, 1, At, B1); PG8_BAR; PG8_SCHED;
            PG8_LDB(B0, 1, 0); PG8_LDB(B1, 1, 1); PG8_SCHED; PG8_LDA(At, 1, 0); PG8_STAGE(PG8_SA(0, 1), a2 + hstep, voffA);
            PG8_WAIT_V(8); PG8_WAIT_L(0); PG8_BAR; PG8_MMA(0, 0, At, B0); PG8_MMA(0, 1, At, B1); PG8_BAR; PG8_SCHED;
            PG8_LDA(At, 1, 1); PG8_STAGE(PG8_SB(1, 0), b3, voffB); PG8_STAGE(PG8_SB(1, 1), b3 + hstep, voffB); PG8_STAGE(PG8_SA(1, 0), a3, voffA);
            PG8_WAIT_V(8); PG8_WAIT_L(0); PG8_BAR; PG8_MMA(1, 0, At, B0); PG8_MMA(1, 1, At, B1); PG8_BAR; PG8_SCHED;
            } else {
            PG8_LDB(B0, 0, 0); PG8_SCHED; PG8_LDA(At, 0, 0); PG8_STAGE(PG8_SA(1, 1), a1 + hstep, voffA);
            PG8_WAIT_L(8); PG8_BAR; PG8_WAIT_L(0); PG8_MMA(0, 0, At, B0); PG8_BAR; PG8_SCHED;
            PG8_LDB(B1, 0, 1); PG8_STAGE(PG8_SB(0, 0), b2, voffB);
            PG8_BAR; PG8_WAIT_L(0); PG8_MMA(0, 1, At, B1); PG8_BAR;
            PG8_LDA(At, 0, 1); PG8_STAGE(PG8_SA(0, 0), a2, voffA);
            PG8_BAR; PG8_WAIT_L(0); PG8_MMA(1, 0, At, B0); PG8_BAR; PG8_SCHED;
            PG8_STAGE(PG8_SB(0, 1), b2 + hstep, voffB);
            PG8_WAIT_V(6); PG8_BAR; PG8_MMA(1, 1, At, B1); PG8_BAR;
            PG8_LDB(B0, 1, 0); PG8_SCHED; PG8_LDA(At, 1, 0); PG8_STAGE(PG8_SA(0, 1), a2 + hstep, voffA);
            PG8_WAIT_L(8); PG8_BAR; PG8_WAIT_L(0); PG8_MMA(0, 0, At, B0); PG8_BAR; PG8_SCHED;
            PG8_LDB(B1, 1, 1); PG8_STAGE(PG8_SB(1, 0), b3, voffB);
            PG8_BAR; PG8_WAIT_L(0); PG8_MMA(0, 1, At, B1); PG8_BAR;
            PG8_LDA(At, 1, 1); PG8_STAGE(PG8_SA(1, 0), a3, voffA);
            PG8_BAR; PG8_WAIT_L(0); PG8_MMA(1, 0, At, B0); PG8_BAR; PG8_SCHED;
            PG8_STAGE(PG8_SB(1, 1), b3 + hstep, voffB);
            PG8_WAIT_V(6); PG8_BAR; PG8_MMA(1, 1, At, B1); PG8_BAR;
            }
        }
        if constexpr (ALIGN_EPI) { if (wr == 0) PG8_BAR; }
        if constexpr (!Epi::AFTER_DRAIN) { E(acc, cur, wr, wc, fr, fq); S.done(cur); }
        if (!has_next) break;
#pragma unroll
        for (int a = 0; a < 2; ++a)
#pragma unroll
            for (int b = 0; b < 2; ++b)
#pragma unroll
                for (int m = 0; m < 4; ++m)
#pragma unroll
                    for (int n = 0; n < 2; ++n) acc[a][b][m][n] = (f32x4){0.f, 0.f, 0.f, 0.f};
        cur = nxt; cA = nA; cB = nB; ++ui;
        if constexpr (ALIGN_EPI) { if (wr == 1) PG8_BAR; }
    }
    PG8_WAIT_V(0);
    if constexpr (!ALIGN_EPI) { if (wr == 0) PG8_BAR; }
    PG8_BAR;
    if constexpr (Epi::AFTER_DRAIN) { E.fused(acc, cur, wr, wc, fr, fq, lds, wid, lane); S.done(cur); }
#undef PG8_SA
#undef PG8_SB
#undef PG8_STAGE
#undef PG8_LDA
#undef PG8_LDB
#undef PG8_MMA
#undef PG8_WAIT_V
#undef PG8_WAIT_L
#undef PG8_BAR
#undef PG8_SCHED
}
}

namespace att {
#define LAS __attribute__((address_space(3)))
typedef unsigned short bf16_t;
typedef short bf16x8 __attribute__((ext_vector_type(8)));
typedef short s16x4 __attribute__((ext_vector_type(4)));
typedef float f32x16 __attribute__((ext_vector_type(16)));
typedef float f32x4 __attribute__((ext_vector_type(4)));
typedef unsigned u32x4 __attribute__((ext_vector_type(4)));
constexpr int KST = 72;
constexpr int VST = 136;
constexpr int K2E = 128 * KST, V2E = 64 * VST;
constexpr int L_K = 0, L_V = 2 * K2E * 2, L_CS = L_V + 2 * V2E * 2, L_WS = L_CS + 8192, L_SCAN = L_WS + 2048, L_FLG = L_SCAN + 64, L_END = L_FLG + 64;
constexpr float SB_DONE = 1e-36f;
__device__ __forceinline__ int crow(int r, int hi) { return (r & 3) + 8 * (r >> 2) + 4 * hi; }
typedef float f32x2_t __attribute__((ext_vector_type(2))); typedef __bf16 bf16x2_t __attribute__((ext_vector_type(2)));
__device__ __forceinline__ unsigned pk(float lo, float hi) { f32x2_t v = {lo, hi}; bf16x2_t b = __builtin_convertvector(v, bf16x2_t); return __builtin_bit_cast(unsigned, b); }

__device__ __forceinline__ void qk_tile(f32x16& p0, f32x16& p1, const LAS bf16_t* kb, const bf16x8 (&qr)[4], int r32, int hi) {
#pragma unroll
    for (int d0 = 0; d0 < 4; ++d0) {
        const bf16x8 a0 = *(const LAS bf16x8*)(kb + r32 * KST + d0 * 16 + hi * 8);
        const bf16x8 a1 = *(const LAS bf16x8*)(kb + (32 + r32) * KST + d0 * 16 + hi * 8);
        p0 = __builtin_amdgcn_mfma_f32_32x32x16_bf16(a0, qr[d0], p0, 0, 0, 0);
        p1 = __builtin_amdgcn_mfma_f32_32x32x16_bf16(a1, qr[d0], p1, 0, 0, 0);
    }
}
__device__ __forceinline__ void pack4(bf16x8 (&pa)[4], const f32x16& p0, const f32x16& p1) {
    u32x4 w;
    w.x = pk(p0[0], p0[1]); w.y = pk(p0[2], p0[3]); w.z = pk(p0[4], p0[5]); w.w = pk(p0[6], p0[7]); pa[0] = __builtin_bit_cast(bf16x8, w);
    w.x = pk(p0[8], p0[9]); w.y = pk(p0[10], p0[11]); w.z = pk(p0[12], p0[13]); w.w = pk(p0[14], p0[15]); pa[1] = __builtin_bit_cast(bf16x8, w);
    w.x = pk(p1[0], p1[1]); w.y = pk(p1[2], p1[3]); w.z = pk(p1[4], p1[5]); w.w = pk(p1[6], p1[7]); pa[2] = __builtin_bit_cast(bf16x8, w);
    w.x = pk(p1[8], p1[9]); w.y = pk(p1[10], p1[11]); w.z = pk(p1[12], p1[13]); w.w = pk(p1[14], p1[15]); pa[3] = __builtin_bit_cast(bf16x8, w);
}
template <bool SUMS>
__device__ __forceinline__ void pv_tile(f32x16& o0, f32x16& o1, f32x16& o2, const bf16x8 (&pa)[4], const LAS bf16_t* vb, int r32, int hi) {
    const bf16x8 ones = {0x3F80, 0x3F80, 0x3F80, 0x3F80, 0x3F80, 0x3F80, 0x3F80, 0x3F80};
#pragma unroll
    for (int c = 0; c < 4; ++c) {
        const s16x4 l0 = *(const LAS s16x4*)(vb + r32 * VST + 16 * c + 4 * hi), h0 = *(const LAS s16x4*)(vb + r32 * VST + 16 * c + 8 + 4 * hi);
        const s16x4 l1 = *(const LAS s16x4*)(vb + (32 + r32) * VST + 16 * c + 4 * hi), h1 = *(const LAS s16x4*)(vb + (32 + r32) * VST + 16 * c + 8 + 4 * hi);
        const bf16x8 b0 = {l0[0], l0[1], l0[2], l0[3], h0[0], h0[1], h0[2], h0[3]}, b1 = {l1[0], l1[1], l1[2], l1[3], h1[0], h1[1], h1[2], h1[3]};
        o0 = __builtin_amdgcn_mfma_f32_32x32x16_bf16(pa[c], b0, o0, 0, 0, 0);
        o1 = __builtin_amdgcn_mfma_f32_32x32x16_bf16(pa[c], b1, o1, 0, 0, 0);
        if (SUMS) o2 = __builtin_amdgcn_mfma_f32_32x32x16_bf16(pa[c], ones, o2, 0, 0, 0);
    }
}

template <int MODE>
__device__ __forceinline__ void attn_unit(LAS unsigned char* lds, const bf16_t* __restrict__ Qg, int qpitch, const bf16_t* __restrict__ Kg, int kpitch,
                                          const bf16_t* __restrict__ VTg, int vpitch, bf16_t* __restrict__ Og, int q0, int NT2  , const float* __restrict__ logf) {
    const int tid = opaque_tid(), lane = tid & 63, r32 = lane & 31, hi = lane >> 5;
    const int wid = __builtin_amdgcn_readfirstlane(tid >> 6);
    LAS bf16_t* KS = (LAS bf16_t*)(lds + L_K); LAS bf16_t* VS = (LAS bf16_t*)(lds + L_V);
    LAS float* CS = (LAS float*)(lds + L_CS); LAS float* WS = (LAS float*)(lds + L_WS) + wid * 64;
    LAS float* SCAN = (LAS float*)(lds + L_SCAN); LAS int* FLG = (LAS int*)(lds + L_FLG);
    const int kr = tid >> 3, kc = (tid & 7) * 8, vr = tid >> 4, vc = (tid & 15) * 8;
    const int qmin = q0 + wid * 32, qmax = qmin + 31, qrow = qmin + r32;
    bf16x8 qr[4];
#pragma unroll
    for (int d0 = 0; d0 < 4; ++d0) qr[d0] = *(const bf16x8*)(Qg + (size_t)qrow * qpitch + d0 * 16 + hi * 8);
    if (MODE == 0 && logf != nullptr) {
        const int kvlen = q0 + 256; float v[4];
        { f32x4 lv = {0.f, 0.f, 0.f, 0.f}; if (4 * tid < kvlen) lv = *(const f32x4*)(logf + 4 * tid); v[0] = lv[0]; v[1] = lv[1]; v[2] = lv[2]; v[3] = lv[3]; }
        v[1] += v[0]; v[2] += v[1]; v[3] += v[2];
        const float tot = v[3]; float inc = tot;
#pragma unroll
        for (int off = 1; off < 64; off <<= 1) { const float t = __shfl_up(inc, off); if (lane >= off) inc += t; }
        if (lane == 63) SCAN[wid] = inc;
        __syncthreads();
        float base = 0.f;
#pragma unroll
        for (int w = 0; w < 8; ++w) base += (w < wid) ? SCAN[w] : 0.f;
        const float ex = base + inc - tot;
        { f32x4 cv = {-(ex + v[0]), -(ex + v[1]), -(ex + v[2]), -(ex + v[3])}; *(LAS f32x4*)(CS + 4 * tid) = cv; }
        __syncthreads();
    }
    u32x4 kreg0, kreg1, vreg0, vreg1;
#define LOADT(t) do { const bf16_t* kp_ = Kg + (size_t)((t) * 128 + kr) * kpitch + kc; kreg0 = *(const u32x4*)kp_; kreg1 = *(const u32x4*)(kp_ + (size_t)64 * kpitch); \
                      const bf16_t* vp_ = VTg + (size_t)vr * vpitch + (t) * 128 + vc; vreg0 = *(const u32x4*)vp_; vreg1 = *(const u32x4*)(vp_ + (size_t)32 * vpitch); } while (0)
#define STORET(b) do { LAS bf16_t* kd_ = KS + (b) * K2E + kr * KST + kc; *(LAS u32x4*)kd_ = kreg0; *(LAS u32x4*)(kd_ + 64 * KST) = kreg1; \
                       LAS bf16_t* vd_ = VS + (b) * V2E + vr * VST + vc; *(LAS u32x4*)vd_ = vreg0; *(LAS u32x4*)(vd_ + 32 * VST) = vreg1; } while (0)
    float m_run = 0.f, R = 1.f; bool wdone = false;
    f32x16 o0, o1, o2;
#pragma unroll
    for (int r = 0; r < 16; ++r) { o0[r] = 0.f; o1[r] = 0.f; o2[r] = 0.f; }
#define CINIT(P0, P1, KV0) do { if (MODE == 0) { _Pragma("unroll") for (int g = 0; g < 4; ++g) { \
            const f32x4 c0_ = *(const LAS f32x4*)(CS + (KV0) + 8 * g + 4 * hi), c1_ = *(const LAS f32x4*)(CS + (KV0) + 32 + 8 * g + 4 * hi); \
            _Pragma("unroll") for (int j = 0; j < 4; ++j) { P0[4 * g + j] = c0_[j] - m_run; P1[4 * g + j] = c1_[j] - m_run; } } } \
        else { const float ci_ = (MODE == 1) ? -m_run : 0.f; _Pragma("unroll") for (int r = 0; r < 16; ++r) { P0[r] = ci_; P1[r] = ci_; } } } while (0)
#define SOFTMAX(P0, P1, KV0, FIRST) do { \
        if (MODE == 0 && (KV0) + 63 > qmin) { _Pragma("unroll") for (int r = 0; r < 16; ++r) { const int kv_ = (KV0) + crow(r, hi); if (kv_ > qrow) P0[r] = -INFINITY; if (kv_ + 32 > qrow) P1[r] = -INFINITY; } } \
        float rm_; \
        if (FIRST) { rm_ = fmaxf(P0[0], P1[0]); \
            _Pragma("unroll") for (int r = 1; r < 16; ++r) rm_ = fmaxf(rm_, fmaxf(P0[r], P1[r])); \
            rm_ = fmaxf(rm_, __shfl_xor(rm_, 32)); } \
        else {        \
                      \
            int im_ = max(__float_as_int(P0[0]), __float_as_int(P1[0])); \
            _Pragma("unroll") for (int r = 1; r < 16; ++r) im_ = max(im_, max(__float_as_int(P0[r]), __float_as_int(P1[r]))); \
            im_ = max(im_, __shfl_xor(im_, 32)); rm_ = __int_as_float(im_); } \
        dl = 0.f; resc = false; \
        if ((FIRST) || __any(rm_ > 8.0f)) { \
            dl = (FIRST) ? rm_ : fmaxf(rm_, 0.f); m_run += dl; resc = true; \
            _Pragma("unroll") for (int r = 0; r < 16; ++r) { P0[r] -= dl; P1[r] -= dl; } \
            if (!(FIRST)) { const float f_ = __builtin_amdgcn_exp2f(-dl); asm volatile("" ::: "memory"); if (hi == 0) WS[r32] = f_; asm volatile("s_waitcnt lgkmcnt(0)" ::: "memory"); \
                _Pragma("unroll") for (int r = 0; r < 16; ++r) { const float fo_ = WS[crow(r, hi)]; o0[r] *= fo_; o1[r] *= fo_; o2[r] *= fo_; } \
                asm volatile("s_waitcnt lgkmcnt(0)" ::: "memory"); } } \
        _Pragma("unroll") for (int r = 0; r < 16; ++r) { P0[r] = __builtin_amdgcn_exp2f(P0[r]); P1[r] = __builtin_amdgcn_exp2f(P1[r]); } } while (0)
#define SBSTEP(P0, P1, KV0) do { \
        f32x16 L0, L1; \
          \
        _Pragma("unroll") for (int r = 0; r < 16; ++r) { \
            { const float e = __builtin_amdgcn_exp2f(P0[r]); const float om = __builtin_amdgcn_rcpf(1.f + e); L0[r] = om; P0[r] = 1.f - om; } \
            { const float e = __builtin_amdgcn_exp2f(P1[r]); const float om = __builtin_amdgcn_rcpf(1.f + e); L1[r] = om; P1[r] = 1.f - om; } } \
        if ((KV0) + 63 >= qmin) {        \
            _Pragma("unroll") for (int r = 0; r < 16; ++r) { \
                if ((KV0) + crow(r, hi) >= qrow) { L0[r] = 1.f; P0[r] = 0.f; } \
                if ((KV0) + 32 + crow(r, hi) >= qrow) { L1[r] = 1.f; P1[r] = 0.f; } } } \
        float T[8], Tp[8], off[8]; \
        _Pragma("unroll") for (int g = 0; g < 4; ++g) { T[g] = (L0[4 * g] * L0[4 * g + 1]) * (L0[4 * g + 2] * L0[4 * g + 3]); T[4 + g] = (L1[4 * g] * L1[4 * g + 1]) * (L1[4 * g + 2] * L1[4 * g + 3]); } \
        _Pragma("unroll") for (int k = 0; k < 8; ++k) Tp[k] = __shfl_xor(T[k], 32); \
        float suf = 1.f; \
        _Pragma("unroll") for (int k = 7; k >= 0; --k) { off[k] = R * suf * (hi == 0 ? Tp[k] : 1.f); suf *= T[k] * Tp[k]; } \
        _Pragma("unroll") for (int g = 0; g < 4; ++g) { \
            { const float x1 = L0[4 * g + 1], x2 = L0[4 * g + 2], x3 = L0[4 * g + 3]; const float b = off[g]; \
              P0[4 * g + 3] *= b; P0[4 * g + 2] *= b * x3; P0[4 * g + 1] *= b * (x3 * x2); P0[4 * g] *= b * ((x3 * x2) * x1); } \
            { const float x1 = L1[4 * g + 1], x2 = L1[4 * g + 2], x3 = L1[4 * g + 3]; const float b = off[4 + g]; \
              P1[4 * g + 3] *= b; P1[4 * g + 2] *= b * x3; P1[4 * g + 1] *= b * (x3 * x2); P1[4 * g] *= b * ((x3 * x2) * x1); } } \
        R *= suf; wdone = !__any(R > SB_DONE); } while (0)

    constexpr bool REV = (MODE != 1);
    bool started = false;
    LOADT(REV ? NT2 - 1 : 0); STORET(0); __syncthreads();
    for (int it = 0; it < NT2; ++it) {
        const int t = REV ? NT2 - 1 - it : it;
        const bool more = (it + 1 < NT2);
        if (more) LOADT(REV ? t - 1 : t + 1);
        const int kvA = t * 128, kvB = kvA + 64;
        const LAS bf16_t* kb = KS + (it & 1) * K2E; const LAS bf16_t* vb = VS + (it & 1) * V2E;
        f32x16 pA0, pA1, pB0, pB1; bf16x8 pa[4]; float dl = 0.f; bool resc = false;
        if (MODE != 2) {
            const bool actA = (MODE == 1) || (kvA <= qmax), actB = (MODE == 1) || (kvB <= qmax);
            if (actA) {
                CINIT(pA0, pA1, kvA); qk_tile(pA0, pA1, kb, qr, r32, hi);
                if (actB) { CINIT(pB0, pB1, kvB); qk_tile(pB0, pB1, kb + 64 * KST, qr, r32, hi); }
                __builtin_amdgcn_sched_barrier(0);
                if (MODE == 1) {
                    SOFTMAX(pA0, pA1, kvA, (it == 0));
                    pack4(pa, pA0, pA1);
                    pv_tile<true>(o0, o1, o2, pa, vb, r32, hi);
                    if (resc) {
#pragma unroll
                        for (int r = 0; r < 16; ++r) { pB0[r] -= dl; pB1[r] -= dl; }
                    }
                    SOFTMAX(pB0, pB1, kvB, false);
                    pack4(pa, pB0, pB1);
                    pv_tile<true>(o0, o1, o2, pa, vb + 64, r32, hi);
                } else {
                    if (actB) {
                        SOFTMAX(pB0, pB1, kvB, (!started)); started = true;
                        pack4(pa, pB0, pB1);
                        pv_tile<true>(o0, o1, o2, pa, vb + 64, r32, hi);
                        if (resc) {
#pragma unroll
                            for (int r = 0; r < 16; ++r) { pA0[r] -= dl; pA1[r] -= dl; }
                        }
                    }
                    SOFTMAX(pA0, pA1, kvA, (!started)); started = true;
                    pack4(pa, pA0, pA1);
                    pv_tile<true>(o0, o1, o2, pa, vb, r32, hi);
                }
            }
        } else {
            if (kvB < qmax && !wdone) {
                CINIT(pB0, pB1, kvB); qk_tile(pB0, pB1, kb + 64 * KST, qr, r32, hi);
                CINIT(pA0, pA1, kvA); qk_tile(pA0, pA1, kb, qr, r32, hi);
                __builtin_amdgcn_sched_barrier(0);
                SBSTEP(pB0, pB1, kvB);
                pack4(pa, pB0, pB1);
                pv_tile<false>(o0, o1, o2, pa, vb + 64, r32, hi);
                if (!wdone) { SBSTEP(pA0, pA1, kvA); pack4(pa, pA0, pA1); pv_tile<false>(o0, o1, o2, pa, vb, r32, hi); }
            } else if (kvA < qmax && !wdone) {
                CINIT(pA0, pA1, kvA); qk_tile(pA0, pA1, kb, qr, r32, hi);
                SBSTEP(pA0, pA1, kvA); pack4(pa, pA0, pA1); pv_tile<false>(o0, o1, o2, pa, vb, r32, hi);
            }
            if (lane == 0) FLG[(it & 1) * 8 + wid] = wdone ? 1 : 0;
        }
        if (more) STORET((it + 1) & 1);
        __syncthreads();
        if (MODE == 2) { int alld = 1;
#pragma unroll
            for (int w = 0; w < 8; ++w) alld &= FLG[(it & 1) * 8 + w];
            if (alld) break; }
    }
#undef LOADT
#undef STORET
#undef CINIT
#undef SOFTMAX
#undef SBSTEP
    if (MODE != 2) {
#pragma unroll
        for (int r = 0; r < 16; ++r) { const float fo = __builtin_amdgcn_rcpf(o2[r]); o0[r] *= fo; o1[r] *= fo; }
    }
#pragma unroll
    for (int r = 0; r < 16; ++r) { bf16_t* op = Og + (size_t)(qmin + crow(r, hi)) * 1024 + r32;
        op[0] = (bf16_t)(pk(o0[r], 0.f) & 0xffffu); op[32] = (bf16_t)(pk(o1[r], 0.f) & 0xffffu); }
    __syncthreads();
}
#undef LAS
}

#define LAS __attribute__((address_space(3)))
typedef unsigned short bf16;
typedef float f32x4 __attribute__((ext_vector_type(4)));
typedef unsigned v4u __attribute__((ext_vector_type(4)));
constexpr int NB = 16, SEQ = 2048, DM = 1024, MROWS = NB * SEQ, NH = 12, NHM = 4, NMEM = 256, FF = 2816, FF2 = 5632, MEMROWS = NB * NMEM;
constexpr int NWAVES = 8;
constexpr size_t MiB = 1u << 20;
constexpr size_t WS_WINA = 0;
constexpr size_t WS_WB = 6 * MiB;
constexpr size_t WS_WMEM = 11 * MiB;
constexpr size_t WS_WOUT = 13 * MiB;
constexpr size_t WS_WUP = 17 * MiB;
constexpr size_t WS_WDOWN = 39 * MiB;
constexpr size_t WS_SSQ = 50 * MiB;
constexpr size_t WS_LOGF = 51 * MiB;
constexpr size_t WS_MEMB = 53 * MiB;
constexpr size_t WS_MEMK = 61 * MiB;
constexpr size_t WS_MEMVT = 65 * MiB;
constexpr size_t WS_XB = 69 * MiB;
constexpr size_t WS_HALO = 133 * MiB;
constexpr size_t WS_R1 = 177 * MiB;
constexpr size_t WS_Q = WS_R1, WS_K = WS_R1 + 48 * MiB, WS_VT = WS_R1 + 96 * MiB, WS_QM = WS_R1 + 144 * MiB, WS_O = WS_R1 + 160 * MiB, WS_ACT = WS_R1;
constexpr size_t WS_END = WS_R1 + 224 * MiB;
constexpr int LDS_BYTES = 147456;
#ifndef PROBE_REP
#define PROBE_REP 0
#endif
#define NREP(k) ((PROBE_REP == (k)) ? 2 : 1)

constexpr size_t WS_BAR = 50 * MiB + 768 * 1024;
constexpr int XB_LDS_OFF = 131072 + 64;
#define XB_TMO      128
#define XB_XCNT(j)  (256  + 64 * (j))
#define XB_XSUB(j)  (1280 + 64 * (j))
#define XB_XGEN(j)  (2304 + 64 * (j))
#define XB_TOP      3328
#define XB_TOPGEN   3392
#define XCD_BAR_WORDS 3456
#define XB_SPIN_CAP (1u << 18)

__device__ __forceinline__ unsigned xb_ld(unsigned* p)              { return __hip_atomic_load(p, __ATOMIC_RELAXED, __HIP_MEMORY_SCOPE_AGENT); }
__device__ __forceinline__ unsigned xb_add(unsigned* p, unsigned v) { return __hip_atomic_fetch_add(p, v, __ATOMIC_RELAXED, __HIP_MEMORY_SCOPE_AGENT); }
__device__ __forceinline__ unsigned xb_xcc_id() { return (unsigned)__builtin_amdgcn_s_getreg((3 << 11) | 20) & 0xFu; }
#define XB_SPIN(cond, bar) do { unsigned _sp = 0; while (cond) { __builtin_amdgcn_s_sleep(1); \
    if ((++_sp & 255u) == 0u) { if (xb_ld(&(bar)[XB_TMO])) break; if (_sp > XB_SPIN_CAP) { atomicAdd(&(bar)[XB_TMO], 1u); break; } } } } while (0)

struct XcdBarrier {
    unsigned* bar; unsigned x;
    volatile LAS unsigned* st;
};

__device__ __forceinline__ XcdBarrier xcd_barrier_post(unsigned* bar, volatile LAS unsigned* st) {
    XcdBarrier b; b.bar = bar; b.x = xb_xcc_id(); b.st = st;
    if (threadIdx.x == 0) (void)xb_add(&bar[XB_XCNT(b.x)], 1u);
    return b;
}
__device__ __forceinline__ void xcd_barrier_complete(unsigned* bar, unsigned x, unsigned& nloc, unsigned& nx) {
    const unsigned G = gridDim.x * gridDim.y * gridDim.z;
    unsigned sum, cnt, mine, sp = 0u;
    for (;;) {
        sum = 0u; cnt = 0u; mine = 0u;
#pragma unroll
        for (unsigned j = 0; j < 16; ++j) { const unsigned c = xb_ld(&bar[XB_XCNT(j)]); sum += c; cnt += (c > 0u) ? 1u : 0u; mine = (j == x) ? c : mine; }
        if (sum == G) break;
        __builtin_amdgcn_s_sleep(1);
        if ((++sp & 255u) == 0u) { if (xb_ld(&bar[XB_TMO])) break; if (sp > XB_SPIN_CAP) { atomicAdd(&bar[XB_TMO], 1u); break; } }
    }
    nloc = mine > 0u ? mine : 1u; nx = cnt > 0u ? cnt : 1u;
}

__device__ __forceinline__ void xcd_barrier(const XcdBarrier& b) {
    asm volatile("s_waitcnt vmcnt(0)" ::: "memory");
    __syncthreads();
    if (threadIdx.x == 0) {
        unsigned* bar = b.bar;
        __builtin_amdgcn_s_waitcnt(0);
        unsigned nloc = b.st[0], nx = b.st[1];
        if (nloc == 0u) { xcd_barrier_complete(bar, b.x, nloc, nx); b.st[0] = nloc; b.st[1] = nx; }
        const unsigned old = xb_add(&bar[XB_XSUB(b.x)], 1u);
        const unsigned gen = old / nloc;
        if (old + 1u == (gen + 1u) * nloc) {
            __builtin_amdgcn_fence(__ATOMIC_RELEASE, "agent");
            asm volatile("s_waitcnt vmcnt(0)" ::: "memory");
            const unsigned og = xb_add(&bar[XB_TOP], 1u);
            const unsigned tg = og / nx;
            if (og + 1u == (tg + 1u) * nx) xb_add(&bar[XB_TOPGEN], 1u);
            else XB_SPIN(xb_ld(&bar[XB_TOPGEN]) == tg, bar);
            __builtin_amdgcn_fence(__ATOMIC_ACQUIRE, "agent");
            xb_add(&bar[XB_XGEN(b.x)], 1u);
            asm volatile("s_waitcnt vmcnt(0)" ::: "memory");
        } else {
            XB_SPIN(xb_ld(&bar[XB_XGEN(b.x)]) == gen, bar);
            __builtin_amdgcn_fence(__ATOMIC_ACQUIRE, "agent");
            asm volatile("s_waitcnt vmcnt(0)" ::: "memory");
        }
    }
    __syncthreads();
}

struct Args { const float* in[17]; float* out; unsigned char* ws; };

__device__ __forceinline__ float wave_sum(float v) {
#pragma unroll
    for (int o = 1; o < 64; o <<= 1) v += __shfl_xor(v, o);
    return v;
}
__device__ __forceinline__ unsigned pk2(float lo, float hi) { return pg8::cvt_pk_bf16(lo, hi); }

__device__ __forceinline__ void tr_item(const float* __restrict__ W, int ldw, const float* __restrict__ g, bf16* __restrict__ WT, int K, int r0, int k0, int src0, int nvalid, LAS float* scr, int lane) {
    const int n4 = (lane & 7) * 4, kq = lane >> 3;
    f32x4 tv[8];
#pragma unroll
    for (int i = 0; i < 8; ++i) { const int kk = 8 * i + kq; f32x4 v = {0.f, 0.f, 0.f, 0.f};
        if (n4 < nvalid) { v = __builtin_nontemporal_load((const f32x4*)(W + (size_t)(k0 + kk) * ldw + src0 + n4)); if (g) v = v * g[k0 + kk]; }
        tv[i] = v; }
#pragma unroll
    for (int i = 0; i < 8; ++i) { const int kk = 8 * i + kq; LAS float* d = scr + kk * 33 + n4; d[0] = tv[i][0]; d[1] = tv[i][1]; d[2] = tv[i][2]; d[3] = tv[i][3]; }
    asm volatile("s_waitcnt lgkmcnt(0)" ::: "memory");
    const int c = lane & 7;
#pragma unroll
    for (int j = 0; j < 4; ++j) { const int n = (lane >> 3) + 8 * j; const LAS float* s = scr + (8 * c) * 33 + n;
        v4u o; o.x = pk2(s[0 * 33], s[1 * 33]); o.y = pk2(s[2 * 33], s[3 * 33]); o.z = pk2(s[4 * 33], s[5 * 33]); o.w = pk2(s[6 * 33], s[7 * 33]);
        *(v4u*)(WT + (size_t)(r0 + n) * K + k0 + 8 * c) = o; }
    asm volatile("s_waitcnt lgkmcnt(0)" ::: "memory");
}

__device__ __forceinline__ void row_cvt(const float* __restrict__ xrow, bf16* __restrict__ orow, float* ssq, int lane) {
    const f32x4* xr = (const f32x4*)xrow + lane; f32x4 v[4]; float s = 0.f;
#pragma unroll
    for (int j = 0; j < 4; ++j) { v[j] = __builtin_nontemporal_load(&xr[64 * j]); s += (v[j].x * v[j].x + v[j].y * v[j].y) + (v[j].z * v[j].z + v[j].w * v[j].w); }
    s = wave_sum(s);
    unsigned long long* o8 = (unsigned long long*)orow + lane;
#pragma unroll
    for (int j = 0; j < 4; ++j) o8[64 * j] = (unsigned long long)pk2(v[j].x, v[j].y) | ((unsigned long long)pk2(v[j].z, v[j].w) << 32);
    if (lane == 0) *ssq = s;
}

typedef const __attribute__((address_space(4))) Args* KArgs;
#define PTRS() \
    KArgs ka_ = (KArgs)__builtin_amdgcn_kernarg_segment_ptr(); asm volatile("" : "+s"(ka_)); \
    const int tid = opaque_tid(), lane = tid & 63, wave = __builtin_amdgcn_readfirstlane(tid >> 6); (void)lane; (void)wave; \
    unsigned char* ws = ka_->ws; \
    const float* x = ka_->in[0]; const float* mem = ka_->in[1]; const float* ln_mix_g = ka_->in[2]; const float* w_in_a = ka_->in[3]; const float* b_f_a = ka_->in[4]; \
    const float* w_in_b = ka_->in[5]; const float* ln_kv_g = ka_->in[6]; const float* w_kv = ka_->in[7]; const float* ln_mem_g = ka_->in[8]; const float* w_memkv = ka_->in[9]; \
    const float* w_out = ka_->in[10]; const float* ln_ffn_g = ka_->in[11]; const float* w_up = ka_->in[12]; const float* conv_w = ka_->in[13]; const float* conv_b = ka_->in[14]; \
    const float* w_down = ka_->in[15]; const float* final_g = ka_->in[16]; \
    float* out = ka_->out; \
    bf16* WINA = (bf16*)(ws + WS_WINA); bf16* WB = (bf16*)(ws + WS_WB); bf16* WMEM = (bf16*)(ws + WS_WMEM); bf16* WOUT = (bf16*)(ws + WS_WOUT); \
    bf16* WUP = (bf16*)(ws + WS_WUP); bf16* WDOWN = (bf16*)(ws + WS_WDOWN); \
    float* SSQ = (float*)(ws + WS_SSQ); float* SSQM = SSQ + 5 * MROWS; float* LOGF = (float*)(ws + WS_LOGF); \
    bf16* MEMB = (bf16*)(ws + WS_MEMB); bf16* MEMK = (bf16*)(ws + WS_MEMK); bf16* MEMVT = (bf16*)(ws + WS_MEMVT); \
    bf16* XB = (bf16*)(ws + WS_XB); float* HALO = (float*)(ws + WS_HALO); \
    bf16* Qb = (bf16*)(ws + WS_Q); bf16* Kb = (bf16*)(ws + WS_K); bf16* VTb = (bf16*)(ws + WS_VT); bf16* QMb = (bf16*)(ws + WS_QM); bf16* Ob = (bf16*)(ws + WS_O); bf16* ACT = (bf16*)(ws + WS_ACT);

__global__ void __launch_bounds__(NWAVES * 64, 2) yoco_fwd(Args args) {
    extern __shared__ __attribute__((aligned(16))) unsigned char lds_raw[];
    LAS unsigned char* lds = (LAS unsigned char*)lds_raw;
    const int G = gridDim.x, bx = blockIdx.x;
    { KArgs kb_ = (KArgs)__builtin_amdgcn_kernarg_segment_ptr(); volatile LAS unsigned* st_ = (volatile LAS unsigned*)(lds + XB_LDS_OFF);
      if (threadIdx.x < 2) st_[threadIdx.x] = 0u;
      __syncthreads();
      (void)xcd_barrier_post((unsigned*)(kb_->ws + WS_BAR), st_); }
#define GBAR() do { KArgs kb_ = (KArgs)__builtin_amdgcn_kernarg_segment_ptr(); asm volatile("" : "+s"(kb_)); XcdBarrier xb_; xb_.bar = (unsigned*)(kb_->ws + WS_BAR); xb_.x = xb_xcc_id(); \
        xb_.st = (volatile LAS unsigned*)(lds + XB_LDS_OFF); xcd_barrier(xb_); } while (0)
    for (int rep = 0; rep < NREP(1); ++rep) {
        PTRS();
        LAS float* scr = (LAS float*)(lds + wave * 16384);
        const int gw = bx * NWAVES + wave, NGW = G * NWAVES;
        constexpr int I0 = 88 * 16, I1 = 48 * 16, I2 = 32 * 16, I3 = 16 * 16, I5 = 32 * 16, I7 = 176 * 16, I9 = 32 * 44;
        constexpr int NITEMS = I0 + I1 + I2 + 2 * I3 + 2 * I5 + 2 * I7 + 2 * I9;
        for (int it = gw; it < NITEMS; it += NGW) {
            int r = it;
            if (r < I0) { const int kb = r / 88, rb = r % 88, r0 = rb * 32; int src0 = r0, nv = 32;
                if (r0 >= 2304 && r0 < 2560) src0 = 2316 + (r0 - 2304); else if (r0 == 2560) { src0 = 2304; nv = 12; } else if (r0 > 2560) { src0 = 0; nv = 0; }
                tr_item(w_in_a, 2572, ln_mix_g, WINA, 1024, r0, kb * 64, src0, nv, scr, lane); continue; } r -= I0;
            if (r < I1) { const int kb = r / 48, rb = r % 48; tr_item(w_kv, 1536, ln_kv_g, WB, 1024, rb * 32, kb * 64, rb * 32, 32, scr, lane); continue; } r -= I1;
            if (r < I2) { const int kb = r / 32, rb = r % 32; tr_item(w_in_b, 1024, ln_mix_g + 1024, WB + (size_t)1536 * 1024, 1024, rb * 32, kb * 64, rb * 32, 32, scr, lane); continue; } r -= I2;
            if (r < 2 * I3) { const int l = r / I3; r -= l * I3; const int kb = r / 16, rb = r % 16;
                tr_item(w_memkv + (size_t)l * 1024 * 512, 512, ln_mem_g + l * 1024, WMEM + (size_t)l * 512 * 1024, 1024, rb * 32, kb * 64, rb * 32, 32, scr, lane); continue; } r -= 2 * I3;
            if (r < 2 * I5) { const int l = r / I5; r -= l * I5; const int kb = r / 32, rb = r % 32;
                tr_item(w_out + (size_t)l * 1024 * 1024, 1024, nullptr, WOUT + (size_t)l * 1024 * 1024, 1024, rb * 32, kb * 64, rb * 32, 32, scr, lane); continue; } r -= 2 * I5;
            if (r < 2 * I7) { const int l = r / I7; r -= l * I7; const int kb = r / 176, rb = r % 176, r0 = rb * 32, pn = r0 >> 8, w = r0 & 255;
                const int src0 = (w < 128) ? (128 * pn + w) : (2816 + 128 * pn + (w - 128));
                tr_item(w_up + (size_t)l * 1024 * 5632, 5632, ln_ffn_g + l * 1024, WUP + (size_t)l * 5632 * 1024, 1024, r0, kb * 64, src0, 32, scr, lane); continue; } r -= 2 * I7;
            { const int l = r / I9; r -= l * I9; const int kb = r / 32, rb = r % 32;
                tr_item(w_down + (size_t)l * 2816 * 1024, 1024, nullptr, WDOWN + (size_t)l * 1024 * 2816, 2816, rb * 32, kb * 64, rb * 32, 32, scr, lane); }
        }
        for (int m = gw; m < MROWS; m += 2 * NGW) {
            const int m2 = m + NGW;
            const f32x4* xa = (const f32x4*)(x + (size_t)m * DM) + lane; const f32x4* xb2 = (const f32x4*)(x + (size_t)(m2 < MROWS ? m2 : m) * DM) + lane;
            f32x4 va[4], vb[4]; float sa = 0.f, sb = 0.f;
#pragma unroll
            for (int j = 0; j < 4; ++j) { va[j] = __builtin_nontemporal_load(&xa[64 * j]); vb[j] = __builtin_nontemporal_load(&xb2[64 * j]); }
#pragma unroll
            for (int j = 0; j < 4; ++j) { sa += (va[j].x * va[j].x + va[j].y * va[j].y) + (va[j].z * va[j].z + va[j].w * va[j].w); sb += (vb[j].x * vb[j].x + vb[j].y * vb[j].y) + (vb[j].z * vb[j].z + vb[j].w * vb[j].w); }
            sa = wave_sum(sa); sb = wave_sum(sb);
            unsigned long long* oa = (unsigned long long*)(XB + (size_t)m * DM) + lane; unsigned long long* ob = (unsigned long long*)(XB + (size_t)m2 * DM) + lane;
#pragma unroll
            for (int j = 0; j < 4; ++j) { oa[64 * j] = (unsigned long long)pk2(va[j].x, va[j].y) | ((unsigned long long)pk2(va[j].z, va[j].w) << 32);
                if (m2 < MROWS) ob[64 * j] = (unsigned long long)pk2(vb[j].x, vb[j].y) | ((unsigned long long)pk2(vb[j].z, vb[j].w) << 32); }
            if (lane == 0) { SSQ[m] = sa; if (m2 < MROWS) SSQ[m2] = sb; }
        }
        for (int mm = gw; mm < MEMROWS; mm += NGW) row_cvt(mem + (size_t)mm * DM, MEMB + (size_t)mm * DM, SSQM + mm, lane);
        for (int i = bx * 512 + tid; i < 4 * MROWS; i += G * 512) SSQ[MROWS + i] = 0.f;
    }
    if (G == 0x7ffffff) cg::this_grid().sync();
    GBAR();

    for (int layer = 0; layer < 2; ++layer) {
        for (int rep = 0; rep < NREP(2); ++rep) {
            PTRS();
#ifndef NO_PROJ
            if (layer == 0) {
                pg8::Gemm g{XB, WINA, MROWS, 2816, 1024}; pg8::PrefOrder S; S.init(MROWS, 2816, G, bx); S.ssq = SSQ; S.cw = nullptr; S.cb = nullptr; S.area = lds + 131072 + 1024; S.n = 0;
                pg8::EpiProj E{0, lds + 131072 + 1024, 0, Qb, Kb, VTb, QMb, LOGF, b_f_a, pg8::QC2};
                pg8::gemm_phase<pg8::EpiProj, pg8::PrefOrder, true, true>(lds, g, S, E);
            } else {
                pg8::Gemm g{XB, WB, MROWS, 2560, 1024}; pg8::PrefOrder S; S.init(MROWS, 2560, G, bx); S.ssq = SSQ + 2 * MROWS; S.cw = nullptr; S.cb = nullptr; S.area = lds + 131072 + 1024; S.n = 0;
                pg8::EpiProj E{1, lds + 131072 + 1024, 0, Qb, Kb, VTb, QMb, LOGF, b_f_a, pg8::QC2};
                pg8::gemm_phase<pg8::EpiProj, pg8::PrefOrder, true, true>(lds, g, S, E);
            }
            if (layer == 0) {
                const int c2 = (bx + G - 128) % G, ml = c2 >> 5;
                if (ml < 2) {
                pg8::Gemm g{MEMB, WMEM + (size_t)ml * 512 * 1024, MEMROWS, 512, 1024}; pg8::PrefOrder S; S.init(MEMROWS, 512, G, c2 & 31); S.ssq = SSQM; S.cw = nullptr; S.cb = nullptr; S.area = lds + 131072 + 1024; S.n = 0;
                pg8::EpiProj E{2, lds + 131072 + 1024, 0, nullptr, MEMK + (size_t)ml * MEMROWS * 256, MEMVT + (size_t)ml * MEMROWS * 256, nullptr, nullptr, nullptr, 1.f};
                pg8::gemm_phase<pg8::EpiProj, pg8::PrefOrder, true, true>(lds, g, S, E);
                }
            }
#endif
        }
        GBAR();
        for (int rep = 0; rep < ((PROBE_REP == 3 && layer == 0) || (PROBE_REP == 4 && layer == 1) ? 2 : 1); ++rep) {
            PTRS();
#ifndef NO_ATT
            const int vcu = (G % 8 == 0) ? (bx & 7) * (G >> 3) + (bx >> 3) : bx;
            for (int p = vcu; p < NB * NH * 4; p += G) {
                const int bh = p >> 2, s = p & 3, b = bh / NH, h = bh % NH;
                const bf16* Qg = Qb + (size_t)b * SEQ * 768 + h * 64; const bf16* Kg = Kb + (size_t)bh * SEQ * 64;
                const bf16* VTg = VTb + (size_t)bh * 64 * SEQ; bf16* Og = Ob + (size_t)b * SEQ * 1024 + h * 64;
                const float* lf = LOGF + (size_t)bh * SEQ;
                for (int i = 0; i < 2; ++i) { const int qb = i ? s : 7 - s;
                    if (layer == 0) att::attn_unit<0>(lds, Qg, 768, Kg, 64, VTg, SEQ, Og, qb * 256, 2 * qb + 2, i ? nullptr : lf);
                    else att::attn_unit<2>(lds, Qg, 768, Kg, 64, VTg, SEQ, Og, qb * 256, 2 * qb + 2, lf); }
            }
            for (int uu = vcu; uu < NB * NHM * 8; uu += G) {
                const int bm = uu >> 3, qb = uu & 7, b = bm >> 2, hm = bm & 3;
                const bf16* Qg = QMb + (size_t)b * SEQ * 256 + hm * 64; const bf16* Kg = MEMK + (size_t)layer * MEMROWS * 256 + (size_t)b * NMEM * 256 + hm * 64;
                const bf16* VTg = MEMVT + (size_t)layer * MEMROWS * 256 + (size_t)bm * 64 * NMEM; bf16* Og = Ob + (size_t)b * SEQ * 1024 + 768 + hm * 64;
                att::attn_unit<1>(lds, Qg, 256, Kg, 256, VTg, NMEM, Og, qb * 256, 2, nullptr);
            }
#endif
        }
        GBAR();
        for (int rep = 0; rep < NREP(5); ++rep) {
            PTRS();
            pg8::Gemm g{Ob, WOUT + (size_t)layer * 1024 * 1024, MROWS, 1024, 1024}; pg8::StaticOrder S; S.init(MROWS, 1024, G, bx);
            pg8::EpiRes E{nullptr, XB, SSQ + (size_t)(1 + 2 * layer) * MROWS, (rep > 0 && G < 100000) ? 1 : 0};
#ifndef NO_RES
            pg8::gemm_phase<pg8::EpiRes, pg8::StaticOrder, true, true>(lds, g, S, E);
#endif
        }
        GBAR();
        for (int rep = 0; rep < ((PROBE_REP == 6 || PROBE_REP == 10) ? 2 : 1); ++rep) {
            PTRS();
            pg8::Gemm g{XB, WUP + (size_t)layer * 5632 * 1024, MROWS, 5632, 1024}; pg8::PrefOrder S; S.init(MROWS, 5632, G, bx); S.ssq = SSQ + (size_t)(1 + 2 * layer) * MROWS; S.cw = conv_w + (size_t)layer * 3 * 5632; S.cb = conv_b + (size_t)layer * 5632; S.area = lds + 131072 + 1024; S.n = 0;
            pg8::EpiUp E{lds + 131072 + 1024, 0, ACT, HALO, (PROBE_REP == 10 && rep > 0 && G < 100000) ? 1 : 0};
#ifndef NO_UP
            pg8::gemm_phase<pg8::EpiUp, pg8::PrefOrder, true, true>(lds, g, S, E);
#endif
        }
        GBAR();
        {
            PTRS();
            const float* cw = conv_w + (size_t)layer * 3 * 5632; const float* cb = conv_b + (size_t)layer * 5632;
            for (int i = bx * 512 + tid; i < 512 * 2 * 704; i += G * 512) {
                const int f = (i % 704) * 4, lr = (i / 704) & 1, grp = i / 1408;
                const bool first = (grp & 31) == 0;
                const float* hc = HALO + (size_t)grp * 8 * 2816; const float* hp = HALO + (size_t)(grp - 1) * 8 * 2816;
                const f32x4 z4 = {0.f, 0.f, 0.f, 0.f};
                f32x4 g2v, g1v, g0v, v2v, v1v, v0v;
                if (lr == 0) { g2v = *(const f32x4*)(hc + f); v2v = *(const f32x4*)(hc + 2816 + f);
                    g1v = first ? z4 : *(const f32x4*)(hp + 3 * 5632 + f); v1v = first ? z4 : *(const f32x4*)(hp + 3 * 5632 + 2816 + f);
                    g0v = first ? z4 : *(const f32x4*)(hp + 2 * 5632 + f); v0v = first ? z4 : *(const f32x4*)(hp + 2 * 5632 + 2816 + f); }
                else { g2v = *(const f32x4*)(hc + 5632 + f); v2v = *(const f32x4*)(hc + 5632 + 2816 + f);
                    g1v = *(const f32x4*)(hc + f); v1v = *(const f32x4*)(hc + 2816 + f);
                    g0v = first ? z4 : *(const f32x4*)(hp + 3 * 5632 + f); v0v = first ? z4 : *(const f32x4*)(hp + 3 * 5632 + 2816 + f); }
                const f32x4 cg_ = *(const f32x4*)(cb + f) + *(const f32x4*)(cw + f) * g0v + *(const f32x4*)(cw + 5632 + f) * g1v + *(const f32x4*)(cw + 2 * 5632 + f) * g2v;
                const f32x4 cv_ = *(const f32x4*)(cb + 2816 + f) + *(const f32x4*)(cw + 2816 + f) * v0v + *(const f32x4*)(cw + 5632 + 2816 + f) * v1v + *(const f32x4*)(cw + 2 * 5632 + 2816 + f) * v2v;
                f32x4 r;
#pragma unroll
                for (int j = 0; j < 4; ++j) { const float e = __builtin_amdgcn_exp2f(-cg_[j] * pg8::LOG2E); r[j] = cg_[j] * __builtin_amdgcn_rcpf(1.f + e) * cv_[j]; }
                pg8::u32x2 w; w.x = pk2(r[0], r[1]); w.y = pk2(r[2], r[3]);
                *(pg8::u32x2*)(ACT + (size_t)(grp * 64 + lr) * 2816 + f) = w;
            }
        }
        GBAR();
        for (int rep = 0; rep < NREP(7); ++rep) {
            PTRS();
            pg8::Gemm g{ACT, WDOWN + (size_t)layer * 1024 * 2816, MROWS, 1024, 2816}; pg8::StaticOrder S; S.init(MROWS, 1024, G, bx);
            pg8::EpiRes E{nullptr, XB, SSQ + (size_t)(2 + 2 * layer) * MROWS, (rep > 0 && G < 100000) ? 1 : 0};
#ifndef NO_RES
            pg8::gemm_phase<pg8::EpiRes, pg8::StaticOrder, true, true>(lds, g, S, E);
#endif
        }
        GBAR();
    }
#if PROBE_REP == 8
    for (int rep = 0; rep < 10; ++rep) GBAR();
#endif
#if PROBE_REP == 9
    for (int rep = 0; rep < 2; ++rep)
#endif
    {
        PTRS();
        const int gw = bx * NWAVES + wave, NGW = G * NWAVES; const float* ssq4 = SSQ + 4 * MROWS;
        for (int m = gw; m < MROWS; m += NGW) {
            const float rstd = rsqrtf(ssq4[m] * (1.0f / 1024.0f) + 1e-6f);
            f32x4* xr = (f32x4*)(out + (size_t)m * DM) + lane; const f32x4* gr = (const f32x4*)final_g + lane;
            const unsigned long long* br = (const unsigned long long*)(XB + (size_t)m * DM) + lane;
#pragma unroll
            for (int j = 0; j < 4; ++j) { const unsigned long long w = br[64 * j]; const unsigned lo = (unsigned)w, hi2 = (unsigned)(w >> 32);
                const f32x4 v = {__uint_as_float(lo << 16), __uint_as_float(lo & 0xffff0000u), __uint_as_float(hi2 << 16), __uint_as_float(hi2 & 0xffff0000u)};
                xr[64 * j] = v * rstd * gr[64 * j]; }
        }
    }
}

extern "C" void kernel_launch(void* const* d_in, const int* in_sizes, int n_in, void* d_out, int out_size, void* d_ws, size_t ws_size, hipStream_t stream) {
    static int grid = 0;
    if (grid == 0) {
        if (n_in != 17 || ws_size < WS_END) { fprintf(stderr, "kernel_launch: unexpected n_in %d / ws %zu\n", n_in, ws_size); grid = -1; return; }
        int dev = 0, cus = 0, per_cu = 0;
        hipGetDevice(&dev); hipDeviceGetAttribute(&cus, hipDeviceAttributeMultiprocessorCount, dev);
        if (hipFuncSetAttribute((const void*)yoco_fwd, hipFuncAttributeMaxDynamicSharedMemorySize, LDS_BYTES) != hipSuccess) { fprintf(stderr, "kernel_launch: hipFuncSetAttribute failed\n"); }
        if (hipOccupancyMaxActiveBlocksPerMultiprocessor(&per_cu, (const void*)yoco_fwd, NWAVES * 64, LDS_BYTES) != hipSuccess || per_cu < 1) { fprintf(stderr, "kernel_launch: occupancy query says %d\n", per_cu); per_cu = 1; }
        (void)hipGetLastError();
        grid = cus * 1;
        if (grid <= 0) grid = 256;
    }
    if (grid < 0) return;
    if (hipMemsetAsync((char*)d_ws + WS_BAR, 0, 16384, stream) != hipSuccess) { fprintf(stderr, "kernel_launch: memset failed\n"); return; }
    Args a{};
    for (int i = 0; i < 17; ++i) a.in[i] = (const float*)d_in[i];
    a.out = (float*)d_out; a.ws = (unsigned char*)d_ws;
    void* kargs[] = {&a};
    hipError_t e = hipLaunchCooperativeKernel((const void*)yoco_fwd, dim3(grid), dim3(NWAVES * 64), kargs, LDS_BYTES, stream);
    if (e != hipSuccess) fprintf(stderr, "cooperative launch failed: %s (grid %d)\n", hipGetErrorString(e), grid);
}
```

```cpp
#include <hip/hip_runtime.h>
#include <hip/hip_cooperative_groups.h>
#include <cstdio>
#include <cstdint>
#include <cmath>
namespace cg = cooperative_groups;
__device__ __forceinline__ int opaque_tid() { int t = threadIdx.x; asm volatile("" : "+v"(t)); return t; }
namespace pg8 {
#define PG8_LAS __attribute__((address_space(3)))
typedef unsigned short bf16_t;
typedef short bf16x8 __attribute__((ext_vector_type(8)));
typedef float f32x4 __attribute__((ext_vector_type(4)));
typedef unsigned u32x4 __attribute__((ext_vector_type(4)));
constexpr int BM = 256, BK = 64, HALF = 128, HTB = HALF * BK * 2  , STAGE_BYTES = 8 * HTB, NXCD = 8, WGM = 2;

__host__ __device__ __forceinline__ int lds_byte(int r, int c) { const int st = (r >> 4) * 2 + (c >> 5), rr = r & 15, cc = c & 31, ob = rr * 64 + cc * 2; return st * 1024 + (ob ^ (((ob >> 9) & 1) << 5)); }
__host__ __device__ __forceinline__ void stage_rc(int b, int& R, int& C) { const int st = b / 1024, sb = b % 1024, swz = sb ^ (((sb >> 9) & 1) << 5); R = (st >> 1) * 16 + swz / 64; C = (st & 1) * 32 + (swz % 64) / 2; }
__host__ __device__ __forceinline__ int perm32(int rho) { const int n = rho >> 4, i = rho & 15; return 8 * (i >> 2) + 4 * n + (i & 3); }

struct Unit { int pm, pn; };
struct Gemm { const bf16_t* A; const bf16_t* Bt; int M, N, K; };

struct StaticOrder {
    int nM, nN, nwg, G, c;
    __host__ __device__ __forceinline__ void init(int M, int N, int G_, int c_) { nM = M / BM; nN = N / BM; nwg = nM * nN; G = G_; c = c_; }
    __host__ __device__ __forceinline__ bool next(int i, Unit& u) const {
        const long L = (long)i * G + c; if (L >= nwg) return false;
        int wgid = (int)L; { const int q = nwg / NXCD, r = nwg % NXCD, xcd = wgid % NXCD, off = wgid / NXCD; wgid = (xcd < r ? xcd * (q + 1) : r * (q + 1) + (xcd - r) * q) + off; }
        const int nig = WGM * nN, gid = wgid / nig, fm = gid * WGM, gsz = (nM - fm) < WGM ? (nM - fm) : WGM;
        u.pm = fm + ((wgid % nig) % gsz); u.pn = (wgid % nig) / gsz; return true;
    }
    __device__ __forceinline__ void a_ready(const Unit&) const {}
    __device__ __forceinline__ void done(const Unit&) const {}
};

constexpr int PREF_SLOT = 5120;
struct PrefOrder : StaticOrder {
    const float* ssq; const float* cw; const float* cb; PG8_LAS unsigned char* area; mutable int n;
    __device__ __forceinline__ void a_ready(const Unit& u) const {
        const int tid = opaque_tid(), lane = tid & 63, wid = __builtin_amdgcn_readfirstlane(tid >> 6);
        PG8_LAS unsigned char* slot = area + (n & 1) * PREF_SLOT; ++n;
        if (wid < 4) __builtin_amdgcn_global_load_lds((const unsigned*)(ssq + (size_t)u.pm * BM + wid * 64 + lane), (PG8_LAS unsigned*)(slot + wid * 256), 4, 0, 0);
        if (cw) { const int kk = wid & 3; const float* src = (kk < 3 ? cw + kk * 5632 : cb) + (wid >= 4 ? 2816 : 0) + u.pn * 128 + lane;
            __builtin_amdgcn_global_load_lds((const unsigned*)src, (PG8_LAS unsigned*)(slot + 1024 + wid * 512), 4, 0, 0);
            __builtin_amdgcn_global_load_lds((const unsigned*)(src + 64), (PG8_LAS unsigned*)(slot + 1024 + wid * 512 + 256), 4, 0, 0); }
    }
};

__device__ __forceinline__ unsigned cvt_pk_bf16(float lo, float hi) { unsigned r; asm volatile("v_cvt_pk_bf16_f32 %0, %1, %2" : "=v"(r) : "v"(lo), "v"(hi)); return r; }
typedef unsigned u32x2 __attribute__((ext_vector_type(2)));
constexpr float LOG2E = 1.4426950408889634f;
constexpr float QC2 = 0.125f * 1.4426950408889634f;
constexpr float NEPS = 1e-6f;

struct EpiProj {
    static constexpr bool PERM = true, AFTER_DRAIN = false, APERM = true;
    int variant;
    const PG8_LAS unsigned char* area; mutable int n;
    bf16_t *Q, *K, *VT, *QM; float* LOGF; const float* bf; float qscale;
    __device__ __forceinline__ void operator()(const f32x4 (&acc)[2][2][4][2], const Unit& u, int wr, int wc, int fr, int fq) const {
        const int row0 = u.pm * BM + wr * 64 + 4 * fr; const int pn = u.pn;
        const PG8_LAS float* pre = (const PG8_LAS float*)(area + (n & 1) * PREF_SLOT); ++n;
        float rs[2][4];
#pragma unroll
        for (int ai = 0; ai < 2; ++ai)
#pragma unroll
            for (int m = 0; m < 4; ++m) rs[ai][m] = rsqrtf(pre[wr * 64 + 4 * fr + ai * HALF + m] * (1.0f / 1024.0f) + NEPS);
        int kind = 0, pitch = 768, cb = 0, S_ = 2048, sh = 11, ncols = 768; bf16_t* dst = Q; float sc = 1.f;
        if (variant == 2) { S_ = 256; sh = 8; ncols = 256; pitch = 256; if (pn == 0) { kind = 0; dst = K; } else { kind = 1; dst = VT; } }
        else if (pn >= 10) { kind = 2; }
        else if (pn == 9) { kind = 0; dst = QM; pitch = 256; sc = QC2; }
        else { const int g = pn / 3; cb = 256 * (pn - 3 * g); const int role = (variant == 0) ? g : (g == 0 ? 1 : (g == 1 ? 2 : 0));
               if (role == 0) { kind = 0; dst = Q; sc = qscale; } else if (role == 1) { kind = 0; dst = K; } else { kind = 1; dst = VT; } }
        if (kind == 0) {
#pragma unroll
            for (int ai = 0; ai < 2; ++ai)
#pragma unroll
                for (int m = 0; m < 4; ++m) { const int row = row0 + ai * HALF + m; const float s = rs[ai][m] * sc;
                    bf16_t* rowp = dst + (size_t)row * pitch + cb + wc * 32 + 8 * fq;
#pragma unroll
                    for (int bj = 0; bj < 2; ++bj) { const f32x4 v0 = acc[ai][bj][m][0] * s, v1 = acc[ai][bj][m][1] * s; u32x4 w;
                        w.x = cvt_pk_bf16(v0[0], v0[1]); w.y = cvt_pk_bf16(v0[2], v0[3]); w.z = cvt_pk_bf16(v1[0], v1[1]); w.w = cvt_pk_bf16(v1[2], v1[3]);
                        *(u32x4*)(rowp + bj * HALF) = w; }
                    asm volatile("" ::: "memory"); }
        } else if (kind == 1) {
#pragma unroll
            for (int ai = 0; ai < 2; ++ai) { const int rowa = row0 + ai * HALF;
                bf16_t* bp = dst + ((size_t)(rowa >> sh) * ncols) * S_ + (rowa & (S_ - 1));
#pragma unroll
                for (int bj = 0; bj < 2; ++bj)
#pragma unroll
                    for (int n = 0; n < 2; ++n) { const int col = cb + bj * HALF + wc * 32 + 8 * fq + 4 * n;
                        const f32x4 v0 = acc[ai][bj][0][n] * rs[ai][0], v1 = acc[ai][bj][1][n] * rs[ai][1], v2 = acc[ai][bj][2][n] * rs[ai][2], v3 = acc[ai][bj][3][n] * rs[ai][3];
#pragma unroll
                        for (int j = 0; j < 4; ++j) { u32x2 w; w.x = cvt_pk_bf16(v0[j], v1[j]); w.y = cvt_pk_bf16(v2[j], v3[j]); *(u32x2*)(bp + (size_t)(col + j) * S_) = w; } }
                asm volatile("" ::: "memory"); }
        } else {
            if (wc == 0 && fq < 2) {
#pragma unroll
                for (int ai = 0; ai < 2; ++ai)
#pragma unroll
                    for (int m = 0; m < 4; ++m) { const int row = row0 + ai * HALF + m; const float s = rs[ai][m];
#pragma unroll
                        for (int n = 0; n < 2; ++n) { const f32x4 v = acc[ai][0][m][n] * s;
#pragma unroll
                            for (int j = 0; j < 4; ++j) { const int col = 8 * fq + 4 * n + j;
                                if (col < 12) { const float f = v[j] + bf[col]; const float ls = -(fmaxf(-f, 0.f) + __logf(1.f + __expf(-fabsf(f))));
                                    LOGF[((size_t)(row >> 11) * 12 + col) * 2048 + (row & 2047)] = ls * LOG2E; } } } }
            }
        }
    }
};

struct EpiRes {
    static constexpr bool PERM = true, AFTER_DRAIN = false, APERM = false;
    const float* basef; bf16_t* xb; float* ssq; int dry;
    __device__ __forceinline__ void operator()(const f32x4 (&acc)[2][2][4][2], const Unit& u, int wr, int wc, int fr, int fq) const {
        const int row0 = u.pm * BM + wr * 64 + fr, col0 = u.pn * BM + wc * 32 + 8 * fq;
#pragma unroll
        for (int ai = 0; ai < 2; ++ai) {
            u32x4 bw[4][2];
            if (!basef) {
#pragma unroll
                for (int m = 0; m < 4; ++m)
#pragma unroll
                    for (int bj = 0; bj < 2; ++bj) bw[m][bj] = *(const u32x4*)(xb + (size_t)(row0 + ai * HALF + m * 16) * 1024 + col0 + bj * HALF);
            }
#pragma unroll
            for (int m = 0; m < 4; ++m) { const int row = row0 + ai * HALF + m * 16; const size_t off = (size_t)row * 1024 + col0; float s = 0.f;
#pragma unroll
                for (int bj = 0; bj < 2; ++bj) { const size_t o2 = off + bj * HALF; f32x4 b0, b1;
                    if (basef) { b0 = *(const f32x4*)(basef + o2); b1 = *(const f32x4*)(basef + o2 + 4); }
                    else { const u32x4 w = bw[m][bj];
                        b0 = (f32x4){__uint_as_float(w.x << 16), __uint_as_float(w.x & 0xffff0000u), __uint_as_float(w.y << 16), __uint_as_float(w.y & 0xffff0000u)};
                        b1 = (f32x4){__uint_as_float(w.z << 16), __uint_as_float(w.z & 0xffff0000u), __uint_as_float(w.w << 16), __uint_as_float(w.w & 0xffff0000u)}; }
                    const f32x4 x0 = b0 + acc[ai][bj][m][0], x1 = b1 + acc[ai][bj][m][1];
                    s += ((x0[0] * x0[0] + x0[1] * x0[1]) + (x0[2] * x0[2] + x0[3] * x0[3])) + ((x1[0] * x1[0] + x1[1] * x1[1]) + (x1[2] * x1[2] + x1[3] * x1[3]));
                    if (!dry) { u32x4 w; w.x = cvt_pk_bf16(x0[0], x0[1]); w.y = cvt_pk_bf16(x0[2], x0[3]); w.z = cvt_pk_bf16(x1[0], x1[1]); w.w = cvt_pk_bf16(x1[2], x1[3]); *(u32x4*)(xb + o2) = w; } }
                s += __shfl_xor(s, 16); s += __shfl_xor(s, 32);
                if (fq == 0 && !dry) atomicAdd(ssq + row, s); }
            asm volatile("" ::: "memory");
        }
    }
};

__device__ __forceinline__ float ror1(float x) { return __builtin_bit_cast(float, __builtin_amdgcn_mov_dpp(__builtin_bit_cast(int, x), 0x121, 0xf, 0xf, false)); }
__device__ __forceinline__ float ror2(float x) { return __builtin_bit_cast(float, __builtin_amdgcn_mov_dpp(__builtin_bit_cast(int, x), 0x122, 0xf, 0xf, false)); }
__device__ __forceinline__ float shr1(float old, float x) { return __builtin_bit_cast(float, __builtin_amdgcn_update_dpp(__builtin_bit_cast(int, old), __builtin_bit_cast(int, x), 0x111, 0xf, 0xf, false)); }
__device__ __forceinline__ float shr2(float old, float x) { return __builtin_bit_cast(float, __builtin_amdgcn_update_dpp(__builtin_bit_cast(int, old), __builtin_bit_cast(int, x), 0x112, 0xf, 0xf, false)); }
struct EpiUp {
    static constexpr bool PERM = true, AFTER_DRAIN = false, APERM = true;
    const PG8_LAS unsigned char* area; mutable int n; bf16_t* act; float* halo; int dry;
    static __device__ __forceinline__ float shr1z(float x) { return __builtin_bit_cast(float, __builtin_amdgcn_mov_dpp(__builtin_bit_cast(int, x), 0x111, 0xf, 0xf, true)); }
    __device__ __forceinline__ void operator()(const f32x4 (&acc)[2][2][4][2], const Unit& u, int wr, int wc, int fr, int fq) const {
        const int rbase = u.pm * BM + wr * 64 + 4 * fr;
        const PG8_LAS float* pre = (const PG8_LAS float*)(area + (n & 1) * PREF_SLOT); ++n;
        if (dry) {
            f32x4 t = {0.f, 0.f, 0.f, 0.f};
#pragma unroll
            for (int ai = 0; ai < 2; ++ai)
#pragma unroll
                for (int bj = 0; bj < 2; ++bj)
#pragma unroll
                    for (int m = 0; m < 4; ++m) { t += acc[ai][bj][m][0]; t += acc[ai][bj][m][1]; }
            if (t[0] + t[1] + t[2] + t[3] == 12345.6789f) halo[rbase] = t[0];
            return;
        }
        float rs[2][4];
#pragma unroll
        for (int ai = 0; ai < 2; ++ai)
#pragma unroll
            for (int m = 0; m < 4; ++m) rs[ai][m] = rsqrtf(pre[wr * 64 + 4 * fr + ai * HALF + m] * (1.0f / 1024.0f) + NEPS);
        const PG8_LAS float* pl = pre + 256 + wc * 32;
#pragma unroll
        for (int n = 0; n < 2; ++n) {
            const int f = u.pn * 128 + wc * 32 + 8 * fq + 4 * n;
            const int po = 8 * fq + 4 * n;
#pragma unroll
            for (int ai = 0; ai < 2; ++ai) {
                const int grp = u.pm * 4 + ai * 2 + wr;
                float* hp = halo + ((size_t)(grp * 4 + (fr == 0 ? 0 : 2)) * 2) * 2816 + f;
                f32x4 cg[4];
                {
                    const f32x4 g0 = *(const PG8_LAS f32x4*)(pl + po), g1 = *(const PG8_LAS f32x4*)(pl + 128 + po), g2 = *(const PG8_LAS f32x4*)(pl + 256 + po), gb = *(const PG8_LAS f32x4*)(pl + 384 + po);
                    f32x4 ug[4];
#pragma unroll
                    for (int m = 0; m < 4; ++m) ug[m] = acc[ai][0][m][n] * rs[ai][m];
                    f32x4 s3, s2;
#pragma unroll
                    for (int j = 0; j < 4; ++j) { s3[j] = shr1z(ug[3][j]); s2[j] = shr1z(ug[2][j]); }
                    cg[0] = gb + g0 * s2 + g1 * s3 + g2 * ug[0]; cg[1] = gb + g0 * s3 + g1 * ug[0] + g2 * ug[1];
                    cg[2] = gb + g0 * ug[0] + g1 * ug[1] + g2 * ug[2]; cg[3] = gb + g0 * ug[1] + g1 * ug[2] + g2 * ug[3];
                    if (fr == 0 || fr == 15) { *(f32x4*)hp = fr == 0 ? ug[0] : ug[2]; *(f32x4*)(hp + 5632) = fr == 0 ? ug[1] : ug[3]; }
                }
                {
                    const f32x4 v0 = *(const PG8_LAS f32x4*)(pl + 512 + po), v1 = *(const PG8_LAS f32x4*)(pl + 640 + po), v2 = *(const PG8_LAS f32x4*)(pl + 768 + po), vb = *(const PG8_LAS f32x4*)(pl + 896 + po);
                    f32x4 uv[4];
#pragma unroll
                    for (int m = 0; m < 4; ++m) uv[m] = acc[ai][1][m][n] * rs[ai][m];
                    f32x4 s3, s2;
#pragma unroll
                    for (int j = 0; j < 4; ++j) { s3[j] = shr1z(uv[3][j]); s2[j] = shr1z(uv[2][j]); }
                    f32x4 cv[4];
                    cv[0] = vb + v0 * s2 + v1 * s3 + v2 * uv[0]; cv[1] = vb + v0 * s3 + v1 * uv[0] + v2 * uv[1];
                    cv[2] = vb + v0 * uv[0] + v1 * uv[1] + v2 * uv[2]; cv[3] = vb + v0 * uv[1] + v1 * uv[2] + v2 * uv[3];
                    if (fr == 0 || fr == 15) { *(f32x4*)(hp + 2816) = fr == 0 ? uv[0] : uv[2]; *(f32x4*)(hp + 5632 + 2816) = fr == 0 ? uv[1] : uv[3]; }
#pragma unroll
                    for (int m = 0; m < 4; ++m) { f32x4 r;
#pragma unroll
                        for (int j = 0; j < 4; ++j) { const float e = __builtin_amdgcn_exp2f(-cg[m][j] * LOG2E); r[j] = cg[m][j] * __builtin_amdgcn_rcpf(1.f + e) * cv[m][j]; }
                        u32x2 w; w.x = cvt_pk_bf16(r[0], r[1]); w.y = cvt_pk_bf16(r[2], r[3]);
                        *(u32x2*)(act + (size_t)(rbase + ai * HALF + m) * 2816 + f) = w; }
                }
                asm volatile("" ::: "memory");
            }
        }
    }
};
template <class Epi, class Sched, bool ALIGN_EPI = false, bool SP2 = false>
__device__ __forceinline__ void gemm_phase(PG8_LAS unsigned char* lds, const Gemm g, const Sched& S, const Epi& E) {
    const int tid = opaque_tid(), wid = __builtin_amdgcn_readfirstlane(tid >> 6), lane = tid & 63, wr = wid >> 2, wc = wid & 3, fr = lane & 15, fq = lane >> 4;
    const int K = g.K, nt = K / BK;
    unsigned voffA[2], voffB[2];
#pragma unroll
    for (int i = 0; i < 2; ++i) { int R, C; stage_rc(tid * 16 + i * 8192, R, C); const int Rb = Epi::PERM ? ((R & ~31) + perm32(R & 31)) : R;
        const int Ra = Epi::APERM ? ((R & 64) + 4 * (R & 15) + ((R >> 4) & 3)) : R;
        voffA[i] = (unsigned)(Ra * K + C) * 2u; voffB[i] = (unsigned)(Rb * K + C) * 2u; }
    const size_t kstep = (size_t)(BK * 2);
    const size_t hstep = (size_t)HALF * K * 2;
    const size_t tstep = 2 * hstep;
    const unsigned ldsw = (unsigned)wid * 1024u;
    const int aoff = lds_byte(wr * 64 + fr, fq * 8), boff = lds_byte(wc * 32 + fr, fq * 8);
#define PG8_SA(b, h) (((b) * 2 + (h)) * HTB)
#define PG8_SB(b, h) ((4 + (b) * 2 + (h)) * HTB)
#define PG8_STAGE(bufoff, gbase, voff) do { _Pragma("unroll") for (int _i = 0; _i < 2; ++_i) \
        __builtin_amdgcn_global_load_lds((const unsigned*)((const char*)(gbase) + (voff)[_i]), (PG8_LAS unsigned*)(lds + (bufoff) + ldsw + _i * 8192), 16, 0, 0); } while (0)
#define PG8_LDA(dst, b, h) do { _Pragma("unroll") for (int m = 0; m < 4; ++m) _Pragma("unroll") for (int k = 0; k < 2; ++k) dst[m][k] = *(const PG8_LAS bf16x8*)(lds + PG8_SA(b, h) + aoff + m * 2048 + k * 1024); } while (0)
#define PG8_LDB(dst, b, h) do { _Pragma("unroll") for (int n = 0; n < 2; ++n) _Pragma("unroll") for (int k = 0; k < 2; ++k) dst[n][k] = *(const PG8_LAS bf16x8*)(lds + PG8_SB(b, h) + boff + n * 2048 + k * 1024); } while (0)
#define PG8_MMA(ai, bj, At, Bt) do { __builtin_amdgcn_s_setprio(1); _Pragma("unroll") for (int m = 0; m < 4; ++m) _Pragma("unroll") for (int n = 0; n < 2; ++n) _Pragma("unroll") for (int k = 0; k < 2; ++k) \
        acc[ai][bj][m][n] = __builtin_amdgcn_mfma_f32_16x16x32_bf16(Bt[n][k], At[m][k], acc[ai][bj][m][n], 0, 0, 0); __builtin_amdgcn_s_setprio(0); } while (0)
#define PG8_WAIT_V(n) asm volatile("s_waitcnt vmcnt(" #n ")" ::: "memory")
#define PG8_WAIT_L(n) asm volatile("s_waitcnt lgkmcnt(" #n ")" ::: "memory")
#define PG8_BAR __builtin_amdgcn_s_barrier()
#define PG8_SCHED __builtin_amdgcn_sched_barrier(0)
    Unit cur, nxt; int ui = 0;
    if (!S.next(0, cur)) return;
    f32x4 acc[2][2][4][2];
#pragma unroll
    for (int a = 0; a < 2; ++a)
#pragma unroll
        for (int b = 0; b < 2; ++b)
#pragma unroll
            for (int m = 0; m < 4; ++m)
#pragma unroll
                for (int n = 0; n < 2; ++n) acc[a][b][m][n] = (f32x4){0.f, 0.f, 0.f, 0.f};
    bf16x8 At[4][2], B0[2][2], B1[2][2];
    const char* cA = (const char*)g.A + (size_t)cur.pm * tstep; const char* cB = (const char*)g.Bt + (size_t)cur.pn * tstep;
    S.a_ready(cur);
    if constexpr (SP2) {
        PG8_STAGE(PG8_SB(0, 0), cB, voffB); PG8_STAGE(PG8_SB(0, 1), cB + hstep, voffB); PG8_STAGE(PG8_SA(0, 0), cA, voffA); PG8_STAGE(PG8_SA(0, 1), cA + hstep, voffA);
        if (wr == 1) PG8_BAR;
        PG8_WAIT_V(2); PG8_BAR;
        PG8_STAGE(PG8_SB(1, 0), cB + kstep, voffB); PG8_STAGE(PG8_SA(1, 0), cA + kstep, voffA); PG8_STAGE(PG8_SB(1, 1), cB + hstep + kstep, voffB);
        PG8_WAIT_V(6); PG8_BAR;
    } else {
        PG8_STAGE(PG8_SB(0, 0), cB, voffB); PG8_STAGE(PG8_SA(0, 0), cA, voffA); PG8_STAGE(PG8_SB(0, 1), cB + hstep, voffB); PG8_STAGE(PG8_SA(0, 1), cA + hstep, voffA);
        if (wr == 1) PG8_BAR;
        PG8_WAIT_V(4); PG8_BAR;
        PG8_STAGE(PG8_SB(1, 0), cB + kstep, voffB); PG8_STAGE(PG8_SA(1, 0), cA + kstep, voffA); PG8_STAGE(PG8_SB(1, 1), cB + hstep + kstep, voffB);
        PG8_WAIT_V(6); PG8_BAR;
    }
    for (;;) {
        const bool has_next = S.next(ui + 1, nxt);
        const char* nA = has_next ? (const char*)g.A + (size_t)nxt.pm * tstep : cA; const char* nB = has_next ? (const char*)g.Bt + (size_t)nxt.pn * tstep : cB;
        for (int t = 0; t < nt; t += 2) {
            const bool last = (t == nt - 2);
            const char* a1 = cA + (size_t)(t + 1) * kstep;
            const char* a2 = last ? nA : cA + (size_t)(t + 2) * kstep; const char* b2 = last ? nB : cB + (size_t)(t + 2) * kstep;
            const char* a3 = a2 + kstep; const char* b3 = b2 + kstep;
            if (last && has_next) S.a_ready(nxt);
            if constexpr (SP2) {
            PG8_LDB(B0, 0, 0); PG8_LDB(B1, 0, 1); PG8_SCHED; PG8_LDA(At, 0, 0); PG8_STAGE(PG8_SA(1, 1), a1 + hstep, voffA);
            PG8_WAIT_V(8); PG8_WAIT_L(0); PG8_BAR; PG8_MMA(0, 0, At, B0); PG8_MMA(0, 1, At, B1); PG8_BAR; PG8_SCHED;
            PG8_LDA(At, 0, 1); PG8_STAGE(PG8_SB(0, 0), b2, voffB); PG8_STAGE(PG8_SB(0, 1), b2 + hstep, voffB); PG8_STAGE(PG8_SA(0, 0), a2, voffA);
            PG8_WAIT_V(8); PG8_WAIT_L(0); PG8_BAR; PG8_MMA(1, 0, At, B0); PG8_MMA(1, 1, At, B1); PG8_BAR; PG8_SCHED;
            PG8_LDB(B0, 1, 0); PG8_LDB(B1, 1, 1); PG8_SCHED; PG8_LDA(At, 1, 0); PG8_STAGE(PG8_SA(0, 1), a2 + hstep, voffA);
            PG8_WAIT_V(8); PG8_WAIT_L(0); PG8_BAR; PG8_MMA(0, 0, At, B0); PG8_MMA(0, 1, At, B1); PG8_BAR; PG8_SCHED;
            PG8_LDA(At, 1, 1); PG8_STAGE(PG8_SB(1, 0), b3, voffB); PG8_STAGE(PG8_SB(1, 1), b3 + hstep, voffB); PG8_STAGE(PG8_SA(1, 0), a3, voffA);
            PG8_WAIT_V(8); PG8_WAIT_L(0); PG8_BAR; PG8_MMA(1, 0, At, B0); PG8_MMA(1, 1, At, B1); PG8_BAR; PG8_SCHED;
            } else {
            PG8_LDB(B0, 0, 0); PG8_SCHED; PG8_LDA(At, 0, 0); PG8_STAGE(PG8_SA(1, 1), a1 + hstep, voffA);
            PG8_WAIT_L(8); PG8_BAR; PG8_WAIT_L(0); PG8_MMA(0, 0, At, B0); PG8_BAR; PG8_SCHED;
            PG8_LDB(B1, 0, 1); PG8_STAGE(PG8_SB(0, 0), b2, voffB);
            PG8_BAR; PG8_WAIT_L(0); PG8_MMA(0, 1, At, B1); PG8_BAR;
            PG8_LDA(At, 0, 1); PG8_STAGE(PG8_SA(0, 0), a2, voffA);
            PG8_BAR; PG8_WAIT_L(0); PG8_MMA(1, 0, At, B0); PG8_BAR; PG8_SCHED;
            PG8_STAGE(PG8_SB(0, 1), b2 + hstep, voffB);
            PG8_WAIT_V(6); PG8_BAR; PG8_MMA(1, 1, At, B1); PG8_BAR;
            PG8_LDB(B0, 1, 0); PG8_SCHED; PG8_LDA(At, 1, 0); PG8_STAGE(PG8_SA(0, 1), a2 + hstep, voffA);
            PG8_WAIT_L(8); PG8_BAR; PG8_WAIT_L(0); PG8_MMA(0, 0, At, B0); PG8_BAR; PG8_SCHED;
            PG8_LDB(B1, 1, 1); PG8_STAGE(PG8_SB(1, 0), b3, voffB);
            PG8_BAR; PG8_WAIT_L(0); PG8_MMA(0, 1, At, B1); PG8_BAR;
            PG8_LDA(At, 1, 1); PG8_STAGE(PG8_SA(1, 0), a3, voffA);
            PG8_BAR; PG8_WAIT_L(0); PG8_MMA(1, 0, At, B0); PG8_BAR; PG8_SCHED;
            PG8_STAGE(PG8_SB(1, 1), b3 + hstep, voffB);
            PG8_WAIT_V(6); PG8_BAR; PG8_MMA(1, 1, At, B1); PG8_BAR;
            }
        }
        if constexpr (ALIGN_EPI) { if (wr == 0) PG8_BAR; }
        if constexpr (!Epi::AFTER_DRAIN) { E(acc, cur, wr, wc, fr, fq); S.done(cur); }
        if (!has_next) break;
#pragma unroll
        for (int a = 0; a < 2; ++a)
#pragma unroll
            for (int b = 0; b < 2; ++b)
#pragma unroll
                for (int m = 0; m < 4; ++m)
#pragma unroll
                    for (int n = 0; n < 2; ++n) acc[a][b][m][n] = (f32x4){0.f, 0.f, 0.f, 0.f};
        cur = nxt; cA = nA; cB = nB; ++ui;
        if constexpr (ALIGN_EPI) { if (wr == 1) PG8_BAR; }
    }
    PG8_WAIT_V(0);
    if constexpr (!ALIGN_EPI) { if (wr == 0) PG8_BAR; }
    PG8_BAR;
    if constexpr (Epi::AFTER_DRAIN) { E.fused(acc, cur, wr, wc, fr, fq, lds, wid, lane); S.done(cur); }
#undef PG8_SA
#undef PG8_SB
#undef PG8_STAGE
#undef PG8_LDA
#undef PG8_LDB
#undef PG8_MMA
#undef PG8_WAIT_V
#undef PG8_WAIT_L
#undef PG8_BAR
#undef PG8_SCHED
}
}

namespace att {
#define LAS __attribute__((address_space(3)))
typedef unsigned short bf16_t;
typedef short bf16x8 __attribute__((ext_vector_type(8)));
typedef short s16x4 __attribute__((ext_vector_type(4)));
typedef float f32x16 __attribute__((ext_vector_type(16)));
typedef float f32x4 __attribute__((ext_vector_type(4)));
typedef unsigned u32x4 __attribute__((ext_vector_type(4)));
constexpr int KST = 72;
constexpr int VST = 136;
constexpr int K2E = 128 * KST, V2E = 64 * VST;
constexpr int L_K = 0, L_V = 2 * K2E * 2, L_CS = L_V + 2 * V2E * 2, L_WS = L_CS + 8192, L_SCAN = L_WS + 2048, L_FLG = L_SCAN + 64, L_END = L_FLG + 64;
constexpr float SB_DONE = 1e-36f;
__device__ __forceinline__ int crow(int r, int hi) { return (r & 3) + 8 * (r >> 2) + 4 * hi; }
typedef float f32x2_t __attribute__((ext_vector_type(2))); typedef __bf16 bf16x2_t __attribute__((ext_vector_type(2)));
__device__ __forceinline__ unsigned pk(float lo, float hi) { f32x2_t v = {lo, hi}; bf16x2_t b = __builtin_convertvector(v, bf16x2_t); return __builtin_bit_cast(unsigned, b); }

__device__ __forceinline__ void qk_tile(f32x16& p0, f32x16& p1, const LAS bf16_t* kb, const bf16x8 (&qr)[4], int r32, int hi) {
#pragma unroll
    for (int d0 = 0; d0 < 4; ++d0) {
        const bf16x8 a0 = *(const LAS bf16x8*)(kb + r32 * KST + d0 * 16 + hi * 8);
        const bf16x8 a1 = *(const LAS bf16x8*)(kb + (32 + r32) * KST + d0 * 16 + hi * 8);
        p0 = __builtin_amdgcn_mfma_f32_32x32x16_bf16(a0, qr[d0], p0, 0, 0, 0);
        p1 = __builtin_amdgcn_mfma_f32_32x32x16_bf16(a1, qr[d0], p1, 0, 0, 0);
    }
}
__device__ __forceinline__ void pack4(bf16x8 (&pa)[4], const f32x16& p0, const f32x16& p1) {
    u32x4 w;
    w.x = pk(p0[0], p0[1]); w.y = pk(p0[2], p0[3]); w.z = pk(p0[4], p0[5]); w.w = pk(p0[6], p0[7]); pa[0] = __builtin_bit_cast(bf16x8, w);
    w.x = pk(p0[8], p0[9]); w.y = pk(p0[10], p0[11]); w.z = pk(p0[12], p0[13]); w.w = pk(p0[14], p0[15]); pa[1] = __builtin_bit_cast(bf16x8, w);
    w.x = pk(p1[0], p1[1]); w.y = pk(p1[2], p1[3]); w.z = pk(p1[4], p1[5]); w.w = pk(p1[6], p1[7]); pa[2] = __builtin_bit_cast(bf16x8, w);
    w.x = pk(p1[8], p1[9]); w.y = pk(p1[10], p1[11]); w.z = pk(p1[12], p1[13]); w.w = pk(p1[14], p1[15]); pa[3] = __builtin_bit_cast(bf16x8, w);
}
template <bool SUMS>
__device__ __forceinline__ void pv_tile(f32x16& o0, f32x16& o1, f32x16& o2, const bf16x8 (&pa)[4], const LAS bf16_t* vb, int r32, int hi) {
    const bf16x8 ones = {0x3F80, 0x3F80, 0x3F80, 0x3F80, 0x3F80, 0x3F80, 0x3F80, 0x3F80};
#pragma unroll
    for (int c = 0; c < 4; ++c) {
        const s16x4 l0 = *(const LAS s16x4*)(vb + r32 * VST + 16 * c + 4 * hi), h0 = *(const LAS s16x4*)(vb + r32 * VST + 16 * c + 8 + 4 * hi);
        const s16x4 l1 = *(const LAS s16x4*)(vb + (32 + r32) * VST + 16 * c + 4 * hi), h1 = *(const LAS s16x4*)(vb + (32 + r32) * VST + 16 * c + 8 + 4 * hi);
        const bf16x8 b0 = {l0[0], l0[1], l0[2], l0[3], h0[0], h0[1], h0[2], h0[3]}, b1 = {l1[0], l1[1], l1[2], l1[3], h1[0], h1[1], h1[2], h1[3]};
        o0 = __builtin_amdgcn_mfma_f32_32x32x16_bf16(pa[c], b0, o0, 0, 0, 0);
        o1 = __builtin_amdgcn_mfma_f32_32x32x16_bf16(pa[c], b1, o1, 0, 0, 0);
        if (SUMS) o2 = __builtin_amdgcn_mfma_f32_32x32x16_bf16(pa[c], ones, o2, 0, 0, 0);
    }
}

template <int MODE>
__device__ __forceinline__ void attn_unit(LAS unsigned char* lds, const bf16_t* __restrict__ Qg, int qpitch, const bf16_t* __restrict__ Kg, int kpitch,
                                          const bf16_t* __restrict__ VTg, int vpitch, bf16_t* __restrict__ Og, int q0, int NT2  , const float* __restrict__ logf) {
    const int tid = opaque_tid(), lane = tid & 63, r32 = lane & 31, hi = lane >> 5;
    const int wid = __builtin_amdgcn_readfirstlane(tid >> 6);
    LAS bf16_t* KS = (LAS bf16_t*)(lds + L_K); LAS bf16_t* VS = (LAS bf16_t*)(lds + L_V);
    LAS float* CS = (LAS float*)(lds + L_CS); LAS float* WS = (LAS float*)(lds + L_WS) + wid * 64;
    LAS float* SCAN = (LAS float*)(lds + L_SCAN); LAS int* FLG = (LAS int*)(lds + L_FLG);
    const int kr = tid >> 3, kc = (tid & 7) * 8, vr = tid >> 4, vc = (tid & 15) * 8;
    const int qmin = q0 + wid * 32, qmax = qmin + 31, qrow = qmin + r32;
    bf16x8 qr[4];
#pragma unroll
    for (int d0 = 0; d0 < 4; ++d0) qr[d0] = *(const bf16x8*)(Qg + (size_t)qrow * qpitch + d0 * 16 + hi * 8);
    if (MODE == 0 && logf != nullptr) {
        const int kvlen = q0 + 256; float v[4];
        { f32x4 lv = {0.f, 0.f, 0.f, 0.f}; if (4 * tid < kvlen) lv = *(const f32x4*)(logf + 4 * tid); v[0] = lv[0]; v[1] = lv[1]; v[2] = lv[2]; v[3] = lv[3]; }
        v[1] += v[0]; v[2] += v[1]; v[3] += v[2];
        const float tot = v[3]; float inc = tot;
#pragma unroll
        for (int off = 1; off < 64; off <<= 1) { const float t = __shfl_up(inc, off); if (lane >= off) inc += t; }
        if (lane == 63) SCAN[wid] = inc;
        __syncthreads();
        float base = 0.f;
#pragma unroll
        for (int w = 0; w < 8; ++w) base += (w < wid) ? SCAN[w] : 0.f;
        const float ex = base + inc - tot;
        { f32x4 cv = {-(ex + v[0]), -(ex + v[1]), -(ex + v[2]), -(ex + v[3])}; *(LAS f32x4*)(CS + 4 * tid) = cv; }
        __syncthreads();
    }
    u32x4 kreg0, kreg1, vreg0, vreg1;
#define LOADT(t) do { const bf16_t* kp_ = Kg + (size_t)((t) * 128 + kr) * kpitch + kc; kreg0 = *(const u32x4*)kp_; kreg1 = *(const u32x4*)(kp_ + (size_t)64 * kpitch); \
                      const bf16_t* vp_ = VTg + (size_t)vr * vpitch + (t) * 128 + vc; vreg0 = *(const u32x4*)vp_; vreg1 = *(const u32x4*)(vp_ + (size_t)32 * vpitch); } while (0)
#define STORET(b) do { LAS bf16_t* kd_ = KS + (b) * K2E + kr * KST + kc; *(LAS u32x4*)kd_ = kreg0; *(LAS u32x4*)(kd_ + 64 * KST) = kreg1; \
                       LAS bf16_t* vd_ = VS + (b) * V2E + vr * VST + vc; *(LAS u32x4*)vd_ = vreg0; *(LAS u32x4*)(vd_ + 32 * VST) = vreg1; } while (0)
    float m_run = 0.f, R = 1.f; bool wdone = false;
    f32x16 o0, o1, o2;
#pragma unroll
    for (int r = 0; r < 16; ++r) { o0[r] = 0.f; o1[r] = 0.f; o2[r] = 0.f; }
#define CINIT(P0, P1, KV0) do { if (MODE == 0) { _Pragma("unroll") for (int g = 0; g < 4; ++g) { \
            const f32x4 c0_ = *(const LAS f32x4*)(CS + (KV0) + 8 * g + 4 * hi), c1_ = *(const LAS f32x4*)(CS + (KV0) + 32 + 8 * g + 4 * hi); \
            _Pragma("unroll") for (int j = 0; j < 4; ++j) { P0[4 * g + j] = c0_[j] - m_run; P1[4 * g + j] = c1_[j] - m_run; } } } \
        else { const float ci_ = (MODE == 1) ? -m_run : 0.f; _Pragma("unroll") for (int r = 0; r < 16; ++r) { P0[r] = ci_; P1[r] = ci_; } } } while (0)
#define SOFTMAX(P0, P1, KV0, FIRST) do { \
        if (MODE == 0 && (KV0) + 63 > qmin) { _Pragma("unroll") for (int r = 0; r < 16; ++r) { const int kv_ = (KV0) + crow(r, hi); if (kv_ > qrow) P0[r] = -INFINITY; if (kv_ + 32 > qrow) P1[r] = -INFINITY; } } \
        float rm_; \
        if (FIRST) { rm_ = fmaxf(P0[0], P1[0]); \
            _Pragma("unroll") for (int r = 1; r < 16; ++r) rm_ = fmaxf(rm_, fmaxf(P0[r], P1[r])); \
            rm_ = fmaxf(rm_, __shfl_xor(rm_, 32)); } \
        else {        \
                      \
            int im_ = max(__float_as_int(P0[0]), __float_as_int(P1[0])); \
            _Pragma("unroll") for (int r = 1; r < 16; ++r) im_ = max(im_, max(__float_as_int(P0[r]), __float_as_int(P1[r]))); \
            im_ = max(im_, __shfl_xor(im_, 32)); rm_ = __int_as_float(im_); } \
        dl = 0.f; resc = false; \
        if ((FIRST) || __any(rm_ > 8.0f)) { \
            dl = (FIRST) ? rm_ : fmaxf(rm_, 0.f); m_run += dl; resc = true; \
            _Pragma("unroll") for (int r = 0; r < 16; ++r) { P0[r] -= dl; P1[r] -= dl; } \
            if (!(FIRST)) { const float f_ = __builtin_amdgcn_exp2f(-dl); asm volatile("" ::: "memory"); if (hi == 0) WS[r32] = f_; asm volatile("s_waitcnt lgkmcnt(0)" ::: "memory"); \
                _Pragma("unroll") for (int r = 0; r < 16; ++r) { const float fo_ = WS[crow(r, hi)]; o0[r] *= fo_; o1[r] *= fo_; o2[r] *= fo_; } \
                asm volatile("s_waitcnt lgkmcnt(0)" ::: "memory"); } } \
        _Pragma("unroll") for (int r = 0; r < 16; ++r) { P0[r] = __builtin_amdgcn_exp2f(P0[r]); P1[r] = __builtin_amdgcn_exp2f(P1[r]); } } while (0)
#define SBSTEP(P0, P1, KV0) do { \
        f32x16 L0, L1; \
          \
        _Pragma("unroll") for (int r = 0; r < 16; ++r) { \
            { const float e = __builtin_amdgcn_exp2f(P0[r]); const float om = __builtin_amdgcn_rcpf(1.f + e); L0[r] = om; P0[r] = 1.f - om; } \
            { const float e = __builtin_amdgcn_exp2f(P1[r]); const float om = __builtin_amdgcn_rcpf(1.f + e); L1[r] = om; P1[r] = 1.f - om; } } \
        if ((KV0) + 63 >= qmin) {        \
            _Pragma("unroll") for (int r = 0; r < 16; ++r) { \
                if ((KV0) + crow(r, hi) >= qrow) { L0[r] = 1.f; P0[r] = 0.f; } \
                if ((KV0) + 32 + crow(r, hi) >= qrow) { L1[r] = 1.f; P1[r] = 0.f; } } } \
        float T[8], Tp[8], off[8]; \
        _Pragma("unroll") for (int g = 0; g < 4; ++g) { T[g] = (L0[4 * g] * L0[4 * g + 1]) * (L0[4 * g + 2] * L0[4 * g + 3]); T[4 + g] = (L1[4 * g] * L1[4 * g + 1]) * (L1[4 * g + 2] * L1[4 * g + 3]); } \
        _Pragma("unroll") for (int k = 0; k < 8; ++k) Tp[k] = __shfl_xor(T[k], 32); \
        float suf = 1.f; \
        _Pragma("unroll") for (int k = 7; k >= 0; --k) { off[k] = R * suf * (hi == 0 ? Tp[k] : 1.f); suf *= T[k] * Tp[k]; } \
        _Pragma("unroll") for (int g = 0; g < 4; ++g) { \
            { const float x1 = L0[4 * g + 1], x2 = L0[4 * g + 2], x3 = L0[4 * g + 3]; const float b = off[g]; \
              P0[4 * g + 3] *= b; P0[4 * g + 2] *= b * x3; P0[4 * g + 1] *= b * (x3 * x2); P0[4 * g] *= b * ((x3 * x2) * x1); } \
            { const float x1 = L1[4 * g + 1], x2 = L1[4 * g + 2], x3 = L1[4 * g + 3]; const float b = off[4 + g]; \
              P1[4 * g + 3] *= b; P1[4 * g + 2] *= b * x3; P1[4 * g + 1] *= b * (x3 * x2); P1[4 * g] *= b * ((x3 * x2) * x1); } } \
        R *= suf; wdone = !__any(R > SB_DONE); } while (0)

    constexpr bool REV = (MODE != 1);
    bool started = false;
    LOADT(REV ? NT2 - 1 : 0); STORET(0); __syncthreads();
    for (int it = 0; it < NT2; ++it) {
        const int t = REV ? NT2 - 1 - it : it;
        const bool more = (it + 1 < NT2);
        if (more) LOADT(REV ? t - 1 : t + 1);
        const int kvA = t * 128, kvB = kvA + 64;
        const LAS bf16_t* kb = KS + (it & 1) * K2E; const LAS bf16_t* vb = VS + (it & 1) * V2E;
        f32x16 pA0, pA1, pB0, pB1; bf16x8 pa[4]; float dl = 0.f; bool resc = false;
        if (MODE != 2) {
            const bool actA = (MODE == 1) || (kvA <= qmax), actB = (MODE == 1) || (kvB <= qmax);
            if (actA) {
                CINIT(pA0, pA1, kvA); qk_tile(pA0, pA1, kb, qr, r32, hi);
                if (actB) { CINIT(pB0, pB1, kvB); qk_tile(pB0, pB1, kb + 64 * KST, qr, r32, hi); }
                __builtin_amdgcn_sched_barrier(0);
                if (MODE == 1) {
                    SOFTMAX(pA0, pA1, kvA, (it == 0));
                    pack4(pa, pA0, pA1);
                    pv_tile<true>(o0, o1, o2, pa, vb, r32, hi);
                    if (resc) {
#pragma unroll
                        for (int r = 0; r < 16; ++r) { pB0[r] -= dl; pB1[r] -= dl; }
                    }
                    SOFTMAX(pB0, pB1, kvB, false);
                    pack4(pa, pB0, pB1);
                    pv_tile<true>(o0, o1, o2, pa, vb + 64, r32, hi);
                } else {
                    if (actB) {
                        SOFTMAX(pB0, pB1, kvB, (!started)); started = true;
                        pack4(pa, pB0, pB1);
                        pv_tile<true>(o0, o1, o2, pa, vb + 64, r32, hi);
                        if (resc) {
#pragma unroll
                            for (int r = 0; r < 16; ++r) { pA0[r] -= dl; pA1[r] -= dl; }
                        }
                    }
                    SOFTMAX(pA0, pA1, kvA, (!started)); started = true;
                    pack4(pa, pA0, pA1);
                    pv_tile<true>(o0, o1, o2, pa, vb, r32, hi);
                }
            }
        } else {
            if (kvB < qmax && !wdone) {
                CINIT(pB0, pB1, kvB); qk_tile(pB0, pB1, kb + 64 * KST, qr, r32, hi);
                CINIT(pA0, pA1, kvA); qk_tile(pA0, pA1, kb, qr, r32, hi);
                __builtin_amdgcn_sched_barrier(0);
                SBSTEP(pB0, pB1, kvB);
                pack4(pa, pB0, pB1);
                pv_tile<false>(o0, o1, o2, pa, vb + 64, r32, hi);
                if (!wdone) { SBSTEP(pA0, pA1, kvA); pack4(pa, pA0, pA1); pv_tile<false>(o0, o1, o2, pa, vb, r32, hi); }
            } else if (kvA < qmax && !wdone) {
                CINIT(pA0, pA1, kvA); qk_tile(pA0, pA1, kb, qr, r32, hi);
                SBSTEP(pA0, pA1, kvA); pack4(pa, pA0, pA1); pv_tile<false>(o0, o1, o2, pa, vb, r32, hi);
            }
            if (lane == 0) FLG[(it & 1) * 8 + wid] = wdone ? 1 : 0;
        }
        if (more) STORET((it + 1) & 1);
        __syncthreads();
        if (MODE == 2) { int alld = 1;
#pragma unroll
            for (int w = 0; w < 8; ++w) alld &= FLG[(it & 1) * 8 + w];
            if (alld) break; }
    }
#undef LOADT
#undef STORET
#undef CINIT
#undef SOFTMAX
#undef SBSTEP
    if (MODE != 2) {
#pragma unroll
        for (int r = 0; r < 16; ++r) { const float fo = __builtin_amdgcn_rcpf(o2[r]); o0[r] *= fo; o1[r] *= fo; }
    }
#pragma unroll
    for (int r = 0; r < 16; ++r) { bf16_t* op = Og + (size_t)(qmin + crow(r, hi)) * 1024 + r32;
        op[0] = (bf16_t)(pk(o0[r], 0.f) & 0xffffu); op[32] = (bf16_t)(pk(o1[r], 0.f) & 0xffffu); }
    __syncthreads();
}
#undef LAS
}

#define LAS __attribute__((address_space(3)))
typedef unsigned short bf16;
typedef float f32x4 __attribute__((ext_vector_type(4)));
typedef unsigned v4u __attribute__((ext_vector_type(4)));
constexpr int NB = 16, SEQ = 2048, DM = 1024, MROWS = NB * SEQ, NH = 12, NHM = 4, NMEM = 256, FF = 2816, FF2 = 5632, MEMROWS = NB * NMEM;
constexpr int NWAVES = 8;
constexpr size_t MiB = 1u << 20;
constexpr size_t WS_WINA = 0;
constexpr size_t WS_WB = 6 * MiB;
constexpr size_t WS_WMEM = 11 * MiB;
constexpr size_t WS_WOUT = 13 * MiB;
constexpr size_t WS_WUP = 17 * MiB;
constexpr size_t WS_WDOWN = 39 * MiB;
constexpr size_t WS_SSQ = 50 * MiB;
constexpr size_t WS_LOGF = 51 * MiB;
constexpr size_t WS_MEMB = 53 * MiB;
constexpr size_t WS_MEMK = 61 * MiB;
constexpr size_t WS_MEMVT = 65 * MiB;
constexpr size_t WS_XB = 69 * MiB;
constexpr size_t WS_HALO = 133 * MiB;
constexpr size_t WS_R1 = 177 * MiB;
constexpr size_t WS_Q = WS_R1, WS_K = WS_R1 + 48 * MiB, WS_VT = WS_R1 + 96 * MiB, WS_QM = WS_R1 + 144 * MiB, WS_O = WS_R1 + 160 * MiB, WS_ACT = WS_R1;
constexpr size_t WS_END = WS_R1 + 224 * MiB;
constexpr int LDS_BYTES = 147456;
#ifndef PROBE_REP
#define PROBE_REP 0
#endif
#define NREP(k) ((PROBE_REP == (k)) ? 2 : 1)

constexpr size_t WS_BAR = 50 * MiB + 768 * 1024;
constexpr int XB_LDS_OFF = 131072 + 64;
#define XB_TMO      128
#define XB_XCNT(j)  (256  + 64 * (j))
#define XB_XSUB(j)  (1280 + 64 * (j))
#define XB_XGEN(j)  (2304 + 64 * (j))
#define XB_TOP      3328
#define XB_TOPGEN   3392
#define XCD_BAR_WORDS 3456
#define XB_SPIN_CAP (1u << 18)

__device__ __forceinline__ unsigned xb_ld(unsigned* p)              { return __hip_atomic_load(p, __ATOMIC_RELAXED, __HIP_MEMORY_SCOPE_AGENT); }
__device__ __forceinline__ unsigned xb_add(unsigned* p, unsigned v) { return __hip_atomic_fetch_add(p, v, __ATOMIC_RELAXED, __HIP_MEMORY_SCOPE_AGENT); }
__device__ __forceinline__ unsigned xb_xcc_id() { return (unsigned)__builtin_amdgcn_s_getreg((3 << 11) | 20) & 0xFu; }
#define XB_SPIN(cond, bar) do { unsigned _sp = 0; while (cond) { __builtin_amdgcn_s_sleep(1); \
    if ((++_sp & 255u) == 0u) { if (xb_ld(&(bar)[XB_TMO])) break; if (_sp > XB_SPIN_CAP) { atomicAdd(&(bar)[XB_TMO], 1u); break; } } } } while (0)

struct XcdBarrier {
    unsigned* bar; unsigned x;
    volatile LAS unsigned* st;
};

__device__ __forceinline__ XcdBarrier xcd_barrier_post(unsigned* bar, volatile LAS unsigned* st) {
    XcdBarrier b; b.bar = bar; b.x = xb_xcc_id(); b.st = st;
    if (threadIdx.x == 0) (void)xb_add(&bar[XB_XCNT(b.x)], 1u);
    return b;
}
__device__ __forceinline__ void xcd_barrier_complete(unsigned* bar, unsigned x, unsigned& nloc, unsigned& nx) {
    const unsigned G = gridDim.x * gridDim.y * gridDim.z;
    unsigned sum, cnt, mine, sp = 0u;
    for (;;) {
        sum = 0u; cnt = 0u; mine = 0u;
#pragma unroll
        for (unsigned j = 0; j < 16; ++j) { const unsigned c = xb_ld(&bar[XB_XCNT(j)]); sum += c; cnt += (c > 0u) ? 1u : 0u; mine = (j == x) ? c : mine; }
        if (sum == G) break;
        __builtin_amdgcn_s_sleep(1);
        if ((++sp & 255u) == 0u) { if (xb_ld(&bar[XB_TMO])) break; if (sp > XB_SPIN_CAP) { atomicAdd(&bar[XB_TMO], 1u); break; } }
    }
    nloc = mine > 0u ? mine : 1u; nx = cnt > 0u ? cnt : 1u;
}

__device__ __forceinline__ void xcd_barrier(const XcdBarrier& b) {
    asm volatile("s_waitcnt vmcnt(0)" ::: "memory");
    __syncthreads();
    if (threadIdx.x == 0) {
        unsigned* bar = b.bar;
        __builtin_amdgcn_s_waitcnt(0);
        unsigned nloc = b.st[0], nx = b.st[1];
        if (nloc == 0u) { xcd_barrier_complete(bar, b.x, nloc, nx); b.st[0] = nloc; b.st[1] = nx; }
        const unsigned old = xb_add(&bar[XB_XSUB(b.x)], 1u);
        const unsigned gen = old / nloc;
        if (old + 1u == (gen + 1u) * nloc) {
            __builtin_amdgcn_fence(__ATOMIC_RELEASE, "agent");
            asm volatile("s_waitcnt vmcnt(0)" ::: "memory");
            const unsigned og = xb_add(&bar[XB_TOP], 1u);
            const unsigned tg = og / nx;
            if (og + 1u == (tg + 1u) * nx) xb_add(&bar[XB_TOPGEN], 1u);
            else XB_SPIN(xb_ld(&bar[XB_TOPGEN]) == tg, bar);
            __builtin_amdgcn_fence(__ATOMIC_ACQUIRE, "agent");
            xb_add(&bar[XB_XGEN(b.x)], 1u);
            asm volatile("s_waitcnt vmcnt(0)" ::: "memory");
        } else {
            XB_SPIN(xb_ld(&bar[XB_XGEN(b.x)]) == gen, bar);
            __builtin_amdgcn_fence(__ATOMIC_ACQUIRE, "agent");
            asm volatile("s_waitcnt vmcnt(0)" ::: "memory");
        }
    }
    __syncthreads();
}

struct Args { const float* in[17]; float* out; unsigned char* ws; };

__device__ __forceinline__ float wave_sum(float v) {
#pragma unroll
    for (int o = 1; o < 64; o <<= 1) v += __shfl_xor(v, o);
    return v;
}
__device__ __forceinline__ unsigned pk2(float lo, float hi) { return pg8::cvt_pk_bf16(lo, hi); }

__device__ __forceinline__ void tr_item(const float* __restrict__ W, int ldw, const float* __restrict__ g, bf16* __restrict__ WT, int K, int r0, int k0, int src0, int nvalid, LAS float* scr, int lane) {
    const int n4 = (lane & 7) * 4, kq = lane >> 3;
    f32x4 tv[8];
#pragma unroll
    for (int i = 0; i < 8; ++i) { const int kk = 8 * i + kq; f32x4 v = {0.f, 0.f, 0.f, 0.f};
        if (n4 < nvalid) { v = __builtin_nontemporal_load((const f32x4*)(W + (size_t)(k0 + kk) * ldw + src0 + n4)); if (g) v = v * g[k0 + kk]; }
        tv[i] = v; }
#pragma unroll
    for (int i = 0; i < 8; ++i) { const int kk = 8 * i + kq; LAS float* d = scr + kk * 33 + n4; d[0] = tv[i][0]; d[1] = tv[i][1]; d[2] = tv[i][2]; d[3] = tv[i][3]; }
    asm volatile("s_waitcnt lgkmcnt(0)" ::: "memory");
    const int c = lane & 7;
#pragma unroll
    for (int j = 0; j < 4; ++j) { const int n = (lane >> 3) + 8 * j; const LAS float* s = scr + (8 * c) * 33 + n;
        v4u o; o.x = pk2(s[0 * 33], s[1 * 33]); o.y = pk2(s[2 * 33], s[3 * 33]); o.z = pk2(s[4 * 33], s[5 * 33]); o.w = pk2(s[6 * 33], s[7 * 33]);
        *(v4u*)(WT + (size_t)(r0 + n) * K + k0 + 8 * c) = o; }
    asm volatile("s_waitcnt lgkmcnt(0)" ::: "memory");
}

__device__ __forceinline__ void row_cvt(const float* __restrict__ xrow, bf16* __restrict__ orow, float* ssq, int lane) {
    const f32x4* xr = (const f32x4*)xrow + lane; f32x4 v[4]; float s = 0.f;
#pragma unroll
    for (int j = 0; j < 4; ++j) { v[j] = __builtin_nontemporal_load(&xr[64 * j]); s += (v[j].x * v[j].x + v[j].y * v[j].y) + (v[j].z * v[j].z + v[j].w * v[j].w); }
    s = wave_sum(s);
    unsigned long long* o8 = (unsigned long long*)orow + lane;
#pragma unroll
    for (int j = 0; j < 4; ++j) o8[64 * j] = (unsigned long long)pk2(v[j].x, v[j].y) | ((unsigned long long)pk2(v[j].z, v[j].w) << 32);
    if (lane == 0) *ssq = s;
}

typedef const __attribute__((address_space(4))) Args* KArgs;
#define PTRS() \
    KArgs ka_ = (KArgs)__builtin_amdgcn_kernarg_segment_ptr(); asm volatile("" : "+s"(ka_)); \
    const int tid = opaque_tid(), lane = tid & 63, wave = __builtin_amdgcn_readfirstlane(tid >> 6); (void)lane; (void)wave; \
    unsigned char* ws = ka_->ws; \
    const float* x = ka_->in[0]; const float* mem = ka_->in[1]; const float* ln_mix_g = ka_->in[2]; const float* w_in_a = ka_->in[3]; const float* b_f_a = ka_->in[4]; \
    const float* w_in_b = ka_->in[5]; const float* ln_kv_g = ka_->in[6]; const float* w_kv = ka_->in[7]; const float* ln_mem_g = ka_->in[8]; const float* w_memkv = ka_->in[9]; \
    const float* w_out = ka_->in[10]; const float* ln_ffn_g = ka_->in[11]; const float* w_up = ka_->in[12]; const float* conv_w = ka_->in[13]; const float* conv_b = ka_->in[14]; \
    const float* w_down = ka_->in[15]; const float* final_g = ka_->in[16]; \
    float* out = ka_->out; \
    bf16* WINA = (bf16*)(ws + WS_WINA); bf16* WB = (bf16*)(ws + WS_WB); bf16* WMEM = (bf16*)(ws + WS_WMEM); bf16* WOUT = (bf16*)(ws + WS_WOUT); \
    bf16* WUP = (bf16*)(ws + WS_WUP); bf16* WDOWN = (bf16*)(ws + WS_WDOWN); \
    float* SSQ = (float*)(ws + WS_SSQ); float* SSQM = SSQ + 5 * MROWS; float* LOGF = (float*)(ws + WS_LOGF); \
    bf16* MEMB = (bf16*)(ws + WS_MEMB); bf16* MEMK = (bf16*)(ws + WS_MEMK); bf16* MEMVT = (bf16*)(ws + WS_MEMVT); \
    bf16* XB = (bf16*)(ws + WS_XB); float* HALO = (float*)(ws + WS_HALO); \
    bf16* Qb = (bf16*)(ws + WS_Q); bf16* Kb = (bf16*)(ws + WS_K); bf16* VTb = (bf16*)(ws + WS_VT); bf16* QMb = (bf16*)(ws + WS_QM); bf16* Ob = (bf16*)(ws + WS_O); bf16* ACT = (bf16*)(ws + WS_ACT);

__global__ void __launch_bounds__(NWAVES * 64, 2) yoco_fwd(Args args) {
    extern __shared__ __attribute__((aligned(16))) unsigned char lds_raw[];
    LAS unsigned char* lds = (LAS unsigned char*)lds_raw;
    const int G = gridDim.x, bx = blockIdx.x;
    { KArgs kb_ = (KArgs)__builtin_amdgcn_kernarg_segment_ptr(); volatile LAS unsigned* st_ = (volatile LAS unsigned*)(lds + XB_LDS_OFF);
      if (threadIdx.x < 2) st_[threadIdx.x] = 0u;
      __syncthreads();
      (void)xcd_barrier_post((unsigned*)(kb_->ws + WS_BAR), st_); }
#define GBAR() do { KArgs kb_ = (KArgs)__builtin_amdgcn_kernarg_segment_ptr(); asm volatile("" : "+s"(kb_)); XcdBarrier xb_; xb_.bar = (unsigned*)(kb_->ws + WS_BAR); xb_.x = xb_xcc_id(); \
        xb_.st = (volatile LAS unsigned*)(lds + XB_LDS_OFF); xcd_barrier(xb_); } while (0)
    for (int rep = 0; rep < NREP(1); ++rep) {
        PTRS();
        LAS float* scr = (LAS float*)(lds + wave * 16384);
        const int gw = bx * NWAVES + wave, NGW = G * NWAVES;
        constexpr int I0 = 88 * 16, I1 = 48 * 16, I2 = 32 * 16, I3 = 16 * 16, I5 = 32 * 16, I7 = 176 * 16, I9 = 32 * 44;
        constexpr int NITEMS = I0 + I1 + I2 + 2 * I3 + 2 * I5 + 2 * I7 + 2 * I9;
        for (int it = gw; it < NITEMS; it += NGW) {
            int r = it;
            if (r < I0) { const int kb = r / 88, rb = r % 88, r0 = rb * 32; int src0 = r0, nv = 32;
                if (r0 >= 2304 && r0 < 2560) src0 = 2316 + (r0 - 2304); else if (r0 == 2560) { src0 = 2304; nv = 12; } else if (r0 > 2560) { src0 = 0; nv = 0; }
                tr_item(w_in_a, 2572, ln_mix_g, WINA, 1024, r0, kb * 64, src0, nv, scr, lane); continue; } r -= I0;
            if (r < I1) { const int kb = r / 48, rb = r % 48; tr_item(w_kv, 1536, ln_kv_g, WB, 1024, rb * 32, kb * 64, rb * 32, 32, scr, lane); continue; } r -= I1;
            if (r < I2) { const int kb = r / 32, rb = r % 32; tr_item(w_in_b, 1024, ln_mix_g + 1024, WB + (size_t)1536 * 1024, 1024, rb * 32, kb * 64, rb * 32, 32, scr, lane); continue; } r -= I2;
            if (r < 2 * I3) { const int l = r / I3; r -= l * I3; const int kb = r / 16, rb = r % 16;
                tr_item(w_memkv + (size_t)l * 1024 * 512, 512, ln_mem_g + l * 1024, WMEM + (size_t)l * 512 * 1024, 1024, rb * 32, kb * 64, rb * 32, 32, scr, lane); continue; } r -= 2 * I3;
            if (r < 2 * I5) { const int l = r / I5; r -= l * I5; const int kb = r / 32, rb = r % 32;
                tr_item(w_out + (size_t)l * 1024 * 1024, 1024, nullptr, WOUT + (size_t)l * 1024 * 1024, 1024, rb * 32, kb * 64, rb * 32, 32, scr, lane); continue; } r -= 2 * I5;
            if (r < 2 * I7) { const int l = r / I7; r -= l * I7; const int kb = r / 176, rb = r % 176, r0 = rb * 32, pn = r0 >> 8, w = r0 & 255;
                const int src0 = (w < 128) ? (128 * pn + w) : (2816 + 128 * pn + (w - 128));
                tr_item(w_up + (size_t)l * 1024 * 5632, 5632, ln_ffn_g + l * 1024, WUP + (size_t)l * 5632 * 1024, 1024, r0, kb * 64, src0, 32, scr, lane); continue; } r -= 2 * I7;
            { const int l = r / I9; r -= l * I9; const int kb = r / 32, rb = r % 32;
                tr_item(w_down + (size_t)l * 2816 * 1024, 1024, nullptr, WDOWN + (size_t)l * 1024 * 2816, 2816, rb * 32, kb * 64, rb * 32, 32, scr, lane); }
        }
        for (int m = gw; m < MROWS; m += 2 * NGW) {
            const int m2 = m + NGW;
            const f32x4* xa = (const f32x4*)(x + (size_t)m * DM) + lane; const f32x4* xb2 = (const f32x4*)(x + (size_t)(m2 < MROWS ? m2 : m) * DM) + lane;
            f32x4 va[4], vb[4]; float sa = 0.f, sb = 0.f;
#pragma unroll
            for (int j = 0; j < 4; ++j) { va[j] = __builtin_nontemporal_load(&xa[64 * j]); vb[j] = __builtin_nontemporal_load(&xb2[64 * j]); }
#pragma unroll
            for (int j = 0; j < 4; ++j) { sa += (va[j].x * va[j].x + va[j].y * va[j].y) + (va[j].z * va[j].z + va[j].w * va[j].w); sb += (vb[j].x * vb[j].x + vb[j].y * vb[j].y) + (vb[j].z * vb[j].z + vb[j].w * vb[j].w); }
            sa = wave_sum(sa); sb = wave_sum(sb);
            unsigned long long* oa = (unsigned long long*)(XB + (size_t)m * DM) + lane; unsigned long long* ob = (unsigned long long*)(XB + (size_t)m2 * DM) + lane;
#pragma unroll
            for (int j = 0; j < 4; ++j) { oa[64 * j] = (unsigned long long)pk2(va[j].x, va[j].y) | ((unsigned long long)pk2(va[j].z, va[j].w) << 32);
                if (m2 < MROWS) ob[64 * j] = (unsigned long long)pk2(vb[j].x, vb[j].y) | ((unsigned long long)pk2(vb[j].z, vb[j].w) << 32); }
            if (lane == 0) { SSQ[m] = sa; if (m2 < MROWS) SSQ[m2] = sb; }
        }
        for (int mm = gw; mm < MEMROWS; mm += NGW) row_cvt(mem + (size_t)mm * DM, MEMB + (size_t)mm * DM, SSQM + mm, lane);
        for (int i = bx * 512 + tid; i < 4 * MROWS; i += G * 512) SSQ[MROWS + i] = 0.f;
    }
    if (G == 0x7ffffff) cg::this_grid().sync();
    GBAR();

    for (int layer = 0; layer < 2; ++layer) {
        for (int rep = 0; rep < NREP(2); ++rep) {
            PTRS();
#ifndef NO_PROJ
            if (layer == 0) {
                pg8::Gemm g{XB, WINA, MROWS, 2816, 1024}; pg8::PrefOrder S; S.init(MROWS, 2816, G, bx); S.ssq = SSQ; S.cw = nullptr; S.cb = nullptr; S.area = lds + 131072 + 1024; S.n = 0;
                pg8::EpiProj E{0, lds + 131072 + 1024, 0, Qb, Kb, VTb, QMb, LOGF, b_f_a, pg8::QC2};
                pg8::gemm_phase<pg8::EpiProj, pg8::PrefOrder, true, true>(lds, g, S, E);
            } else {
                pg8::Gemm g{XB, WB, MROWS, 2560, 1024}; pg8::PrefOrder S; S.init(MROWS, 2560, G, bx); S.ssq = SSQ + 2 * MROWS; S.cw = nullptr; S.cb = nullptr; S.area = lds + 131072 + 1024; S.n = 0;
                pg8::EpiProj E{1, lds + 131072 + 1024, 0, Qb, Kb, VTb, QMb, LOGF, b_f_a, pg8::QC2};
                pg8::gemm_phase<pg8::EpiProj, pg8::PrefOrder, true, true>(lds, g, S, E);
            }
            if (layer == 0) {
                const int c2 = (bx + G - 128) % G, ml = c2 >> 5;
                if (ml < 2) {
                pg8::Gemm g{MEMB, WMEM + (size_t)ml * 512 * 1024, MEMROWS, 512, 1024}; pg8::PrefOrder S; S.init(MEMROWS, 512, G, c2 & 31); S.ssq = SSQM; S.cw = nullptr; S.cb = nullptr; S.area = lds + 131072 + 1024; S.n = 0;
                pg8::EpiProj E{2, lds + 131072 + 1024, 0, nullptr, MEMK + (size_t)ml * MEMROWS * 256, MEMVT + (size_t)ml * MEMROWS * 256, nullptr, nullptr, nullptr, 1.f};
                pg8::gemm_phase<pg8::EpiProj, pg8::PrefOrder, true, true>(lds, g, S, E);
                }
            }
#endif
        }
        GBAR();
        for (int rep = 0; rep < ((PROBE_REP == 3 && layer == 0) || (PROBE_REP == 4 && layer == 1) ? 2 : 1); ++rep) {
            PTRS();
#ifndef NO_ATT
            const int vcu = (G % 8 == 0) ? (bx & 7) * (G >> 3) + (bx >> 3) : bx;
            for (int p = vcu; p < NB * NH * 4; p += G) {
                const int bh = p >> 2, s = p & 3, b = bh / NH, h = bh % NH;
                const bf16* Qg = Qb + (size_t)b * SEQ * 768 + h * 64; const bf16* Kg = Kb + (size_t)b * SEQ * 768 + h * 64;
                const bf16* VTg = VTb + (size_t)bh * 64 * SEQ; bf16* Og = Ob + (size_t)b * SEQ * 1024 + h * 64;
                const float* lf = LOGF + (size_t)bh * SEQ;
                for (int i = 0; i < 2; ++i) { const int qb = i ? s : 7 - s;
                    if (layer == 0) att::attn_unit<0>(lds, Qg, 768, Kg, 768, VTg, SEQ, Og, qb * 256, 2 * qb + 2, i ? nullptr : lf);
                    else att::attn_unit<2>(lds, Qg, 768, Kg, 768, VTg, SEQ, Og, qb * 256, 2 * qb + 2, lf); }
            }
            for (int uu = vcu; uu < NB * NHM * 8; uu += G) {
                const int bm = uu >> 3, qb = uu & 7, b = bm >> 2, hm = bm & 3;
                const bf16* Qg = QMb + (size_t)b * SEQ * 256 + hm * 64; const bf16* Kg = MEMK + (size_t)layer * MEMROWS * 256 + (size_t)b * NMEM * 256 + hm * 64;
                const bf16* VTg = MEMVT + (size_t)layer * MEMROWS * 256 + (size_t)bm * 64 * NMEM; bf16* Og = Ob + (size_t)b * SEQ * 1024 + 768 + hm * 64;
                att::attn_unit<1>(lds, Qg, 256, Kg, 256, VTg, NMEM, Og, qb * 256, 2, nullptr);
            }
#endif
        }
        GBAR();
        for (int rep = 0; rep < NREP(5); ++rep) {
            PTRS();
            pg8::Gemm g{Ob, WOUT + (size_t)layer * 1024 * 1024, MROWS, 1024, 1024}; pg8::StaticOrder S; S.init(MROWS, 1024, G, bx);
            pg8::EpiRes E{nullptr, XB, SSQ + (size_t)(1 + 2 * layer) * MROWS, (rep > 0 && G < 100000) ? 1 : 0};
#ifndef NO_RES
            pg8::gemm_phase<pg8::EpiRes, pg8::StaticOrder, true, true>(lds, g, S, E);
#endif
        }
        GBAR();
        for (int rep = 0; rep < ((PROBE_REP == 6 || PROBE_REP == 10) ? 2 : 1); ++rep) {
            PTRS();
            pg8::Gemm g{XB, WUP + (size_t)layer * 5632 * 1024, MROWS, 5632, 1024}; pg8::PrefOrder S; S.init(MROWS, 5632, G, bx); S.ssq = SSQ + (size_t)(1 + 2 * layer) * MROWS; S.cw = conv_w + (size_t)layer * 3 * 5632; S.cb = conv_b + (size_t)layer * 5632; S.area = lds + 131072 + 1024; S.n = 0;
            pg8::EpiUp E{lds + 131072 + 1024, 0, ACT, HALO, (PROBE_REP == 10 && rep > 0 && G < 100000) ? 1 : 0};
#ifndef NO_UP
            pg8::gemm_phase<pg8::EpiUp, pg8::PrefOrder, true, true>(lds, g, S, E);
#endif
        }
        GBAR();
        {
            PTRS();
            const float* cw = conv_w + (size_t)layer * 3 * 5632; const float* cb = conv_b + (size_t)layer * 5632;
            for (int i = bx * 512 + tid; i < 512 * 2 * 704; i += G * 512) {
                const int f = (i % 704) * 4, lr = (i / 704) & 1, grp = i / 1408;
                const bool first = (grp & 31) == 0;
                const float* hc = HALO + (size_t)grp * 8 * 2816; const float* hp = HALO + (size_t)(grp - 1) * 8 * 2816;
                const f32x4 z4 = {0.f, 0.f, 0.f, 0.f};
                f32x4 g2v, g1v, g0v, v2v, v1v, v0v;
                if (lr == 0) { g2v = *(const f32x4*)(hc + f); v2v = *(const f32x4*)(hc + 2816 + f);
                    g1v = first ? z4 : *(const f32x4*)(hp + 3 * 5632 + f); v1v = first ? z4 : *(const f32x4*)(hp + 3 * 5632 + 2816 + f);
                    g0v = first ? z4 : *(const f32x4*)(hp + 2 * 5632 + f); v0v = first ? z4 : *(const f32x4*)(hp + 2 * 5632 + 2816 + f); }
                else { g2v = *(const f32x4*)(hc + 5632 + f); v2v = *(const f32x4*)(hc + 5632 + 2816 + f);
                    g1v = *(const f32x4*)(hc + f); v1v = *(const f32x4*)(hc + 2816 + f);
                    g0v = first ? z4 : *(const f32x4*)(hp + 3 * 5632 + f); v0v = first ? z4 : *(const f32x4*)(hp + 3 * 5632 + 2816 + f); }
                const f32x4 cg_ = *(const f32x4*)(cb + f) + *(const f32x4*)(cw + f) * g0v + *(const f32x4*)(cw + 5632 + f) * g1v + *(const f32x4*)(cw + 2 * 5632 + f) * g2v;
                const f32x4 cv_ = *(const f32x4*)(cb + 2816 + f) + *(const f32x4*)(cw + 2816 + f) * v0v + *(const f32x4*)(cw + 5632 + 2816 + f) * v1v + *(const f32x4*)(cw + 2 * 5632 + 2816 + f) * v2v;
                f32x4 r;
#pragma unroll
                for (int j = 0; j < 4; ++j) { const float e = __builtin_amdgcn_exp2f(-cg_[j] * pg8::LOG2E); r[j] = cg_[j] * __builtin_amdgcn_rcpf(1.f + e) * cv_[j]; }
                pg8::u32x2 w; w.x = pk2(r[0], r[1]); w.y = pk2(r[2], r[3]);
                *(pg8::u32x2*)(ACT + (size_t)(grp * 64 + lr) * 2816 + f) = w;
            }
        }
        GBAR();
        for (int rep = 0; rep < NREP(7); ++rep) {
            PTRS();
            pg8::Gemm g{ACT, WDOWN + (size_t)layer * 1024 * 2816, MROWS, 1024, 2816}; pg8::StaticOrder S; S.init(MROWS, 1024, G, bx);
            pg8::EpiRes E{nullptr, XB, SSQ + (size_t)(2 + 2 * layer) * MROWS, (rep > 0 && G < 100000) ? 1 : 0};
#ifndef NO_RES
            pg8::gemm_phase<pg8::EpiRes, pg8::StaticOrder, true, true>(lds, g, S, E);
#endif
        }
        GBAR();
    }
#if PROBE_REP == 8
    for (int rep = 0; rep < 10; ++rep) GBAR();
#endif
#if PROBE_REP == 9
    for (int rep = 0; rep < 2; ++rep)
#endif
    {
        PTRS();
        const int gw = bx * NWAVES + wave, NGW = G * NWAVES; const float* ssq4 = SSQ + 4 * MROWS;
        for (int m = gw; m < MROWS; m += NGW) {
            const float rstd = rsqrtf(ssq4[m] * (1.0f / 1024.0f) + 1e-6f);
            f32x4* xr = (f32x4*)(out + (size_t)m * DM) + lane; const f32x4* gr = (const f32x4*)final_g + lane;
            const unsigned long long* br = (const unsigned long long*)(XB + (size_t)m * DM) + lane;
#pragma unroll
            for (int j = 0; j < 4; ++j) { const unsigned long long w = br[64 * j]; const unsigned lo = (unsigned)w, hi2 = (unsigned)(w >> 32);
                const f32x4 v = {__uint_as_float(lo << 16), __uint_as_float(lo & 0xffff0000u), __uint_as_float(hi2 << 16), __uint_as_float(hi2 & 0xffff0000u)};
                xr[64 * j] = v * rstd * gr[64 * j]; }
        }
    }
}

extern "C" void kernel_launch(void* const* d_in, const int* in_sizes, int n_in, void* d_out, int out_size, void* d_ws, size_t ws_size, hipStream_t stream) {
    static int grid = 0;
    if (grid == 0) {
        if (n_in != 17 || ws_size < WS_END) { fprintf(stderr, "kernel_launch: unexpected n_in %d / ws %zu\n", n_in, ws_size); grid = -1; return; }
        int dev = 0, cus = 0, per_cu = 0;
        hipGetDevice(&dev); hipDeviceGetAttribute(&cus, hipDeviceAttributeMultiprocessorCount, dev);
        if (hipFuncSetAttribute((const void*)yoco_fwd, hipFuncAttributeMaxDynamicSharedMemorySize, LDS_BYTES) != hipSuccess) { fprintf(stderr, "kernel_launch: hipFuncSetAttribute failed\n"); }
        if (hipOccupancyMaxActiveBlocksPerMultiprocessor(&per_cu, (const void*)yoco_fwd, NWAVES * 64, LDS_BYTES) != hipSuccess || per_cu < 1) { fprintf(stderr, "kernel_launch: occupancy query says %d\n", per_cu); per_cu = 1; }
        (void)hipGetLastError();
        grid = cus * 1;
        if (grid <= 0) grid = 256;
    }
    if (grid < 0) return;
    if (hipMemsetAsync((char*)d_ws + WS_BAR, 0, 16384, stream) != hipSuccess) { fprintf(stderr, "kernel_launch: memset failed\n"); return; }
    Args a{};
    for (int i = 0; i < 17; ++i) a.in[i] = (const float*)d_in[i];
    a.out = (float*)d_out; a.ws = (unsigned char*)d_ws;
    void* kargs[] = {&a};
    hipError_t e = hipLaunchCooperativeKernel((const void*)yoco_fwd, dim3(grid), dim3(NWAVES * 64), kargs, LDS_BYTES, stream);
    if (e != hipSuccess) fprintf(stderr, "cooperative launch failed: %s (grid %d)\n", hipGetErrorString(e), grid);
}
```
